# Optimizing an MI355X kernel written in HIP

```python
import jax, jax.numpy as jnp
from jax import lax
import numpy as np

D_MODEL = 1024
BATCH = 16
SEQ = 2048
DEPTH = 2

ATT_HEAD_DIM = 64
ATT_HEADS = 8
ATT_KV_HEADS = 2
ATT_GROUP = ATT_HEADS // ATT_KV_HEADS
ATT_WIDTH = ATT_HEADS * ATT_HEAD_DIM
ATT_KV_WIDTH = ATT_KV_HEADS * ATT_HEAD_DIM
WINDOW = 128
ATT_BLOCK = 128
ROPE_DIM = ATT_HEAD_DIM // 4
ROPE_THETA = 500000.0
MLSTM_HEADS = 4
MLSTM_HEAD_DIM = 128
MLSTM_WIDTH = MLSTM_HEADS * MLSTM_HEAD_DIM
MLSTM_CHUNK = 128
MLSTM_N_GATES = 4 * MLSTM_HEADS
CONV_K = 3
D_FF = ((8 * D_MODEL // 3 + 255) // 256) * 256
NORM_EPS = 1e-6
SPLIT_SIZES = (ATT_WIDTH, ATT_KV_WIDTH, ATT_KV_WIDTH, MLSTM_WIDTH, MLSTM_WIDTH, MLSTM_WIDTH, MLSTM_WIDTH, MLSTM_N_GATES, 2 * D_MODEL)
IN_WIDTH = sum(SPLIT_SIZES)

kernel_name = 'hybrid_bidir_swa_mlstm_macaron'


def rms_norm(x, g):
    xf = x.astype(jnp.float32)
    y = xf * lax.rsqrt(jnp.mean(xf * xf, axis=-1, keepdims=True) + NORM_EPS)
    return (y * g.astype(jnp.float32)).astype(x.dtype)


def swiglu(h, w_gate, w_up, w_down):
    return (jax.nn.silu(h @ w_gate) * (h @ w_up)) @ w_down


def partial_rope(t, positions):
    half = ROPE_DIM // 2
    inv_freq = jnp.power(jnp.float32(ROPE_THETA), -jnp.arange(half, dtype=jnp.float32) * (2.0 / ROPE_DIM))
    ang = positions.astype(jnp.float32)[:, :, None] * inv_freq
    cos = jnp.cos(ang)[:, :, None, :]
    sin = jnp.sin(ang)[:, :, None, :]
    tr = t[..., :ROPE_DIM].astype(jnp.float32)
    t1, t2 = tr[..., :half], tr[..., half:]
    rot = jnp.concatenate([t1 * cos - t2 * sin, t2 * cos + t1 * sin], axis=-1)
    return jnp.concatenate([rot.astype(t.dtype), t[..., ROPE_DIM:]], axis=-1)


def windowed_gqa_with_sink(q, k, v, sink):
    B, S, _, dh = q.shape
    wb = ATT_BLOCK
    nb = S // wb
    f32 = jnp.float32
    qb = q.astype(f32).reshape(B, nb, wb, ATT_KV_HEADS, ATT_GROUP, dh)
    pad = ((0, 0), (wb, wb), (0, 0), (0, 0))
    kp = jnp.pad(k.astype(f32), pad).reshape(B, nb + 2, wb, ATT_KV_HEADS, dh)
    vp = jnp.pad(v.astype(f32), pad).reshape(B, nb + 2, wb, ATT_KV_HEADS, dh)
    kb = jnp.concatenate([kp[:, :-2], kp[:, 1:-1], kp[:, 2:]], axis=2)
    vb = jnp.concatenate([vp[:, :-2], vp[:, 1:-1], vp[:, 2:]], axis=2)
    s = jnp.einsum('bnqhgd,bnkhd->bnhgqk', qb, kb) * (dh ** -0.5)
    qi = jnp.arange(nb)[:, None, None] * wb + jnp.arange(wb)[None, :, None]
    kj = jnp.arange(nb)[:, None, None] * wb - wb + jnp.arange(3 * wb)[None, None, :]
    valid = (jnp.abs(qi - kj) <= WINDOW) & (kj >= 0) & (kj < S)
    s = jnp.where(valid[None, :, None, None], s, -jnp.inf)
    sink_l = sink.astype(f32).reshape(1, 1, ATT_KV_HEADS, ATT_GROUP, 1, 1)
    m = jnp.maximum(jnp.max(s, axis=-1, keepdims=True), sink_l)
    p = jnp.exp(s - m)
    den = jnp.sum(p, axis=-1, keepdims=True) + jnp.exp(sink_l - m)
    o = jnp.einsum('bnhgqk,bnkhd->bnqhgd', p / den, vb)
    return o.reshape(B, S, ATT_HEADS * dh).astype(q.dtype)


def centred_depthwise_conv(u, w, b):
    S = u.shape[1]
    pad = CONV_K // 2
    up = jnp.pad(u, ((0, 0), (pad, pad), (0, 0)))
    out = up[:, 0:S] * w[0]
    for j in range(1, CONV_K):
        out = out + up[:, j:j + S] * w[j]
    return out + b


def mlstm_chunkwise(q, k, v, log_i, log_f):
    B, H, S, dk = q.shape
    dv = v.shape[-1]
    L = MLSTM_CHUNK
    nc = S // L
    q = q.reshape(B, H, nc, L, dk)
    k = k.reshape(B, H, nc, L, dk)
    v = v.reshape(B, H, nc, L, dv)
    li = log_i.reshape(B, H, nc, L)
    b = jnp.cumsum(log_f.reshape(B, H, nc, L), axis=-1)
    b_tot = b[..., -1]
    a = b_tot[..., None] - b + li
    a_max = jnp.max(a, axis=-1)
    w = jnp.exp(a - a_max[..., None])
    kw = k * w[..., None]
    C_loc = jnp.einsum('bhcsk,bhcsv->bhckv', kw, v)
    n_loc = jnp.sum(kw, axis=3)

    def step(carry, inp):
        C, n, m = carry
        C_l, n_l, am, bt = inp
        m_new = jnp.maximum(bt + m, am)
        s_p = jnp.exp(bt + m - m_new)
        s_l = jnp.exp(am - m_new)
        C_new = s_p[..., None, None] * C + s_l[..., None, None] * C_l
        n_new = s_p[..., None] * n + s_l[..., None] * n_l
        return (C_new, n_new, m_new), (C, n, m)

    init = (jnp.zeros((B, H, dk, dv), jnp.float32), jnp.zeros((B, H, dk), jnp.float32), jnp.zeros((B, H), jnp.float32))
    xs = (jnp.moveaxis(C_loc, 2, 0), jnp.moveaxis(n_loc, 2, 0), jnp.moveaxis(a_max, 2, 0), jnp.moveaxis(b_tot, 2, 0))
    _, (C_in, n_in, m_in) = lax.scan(step, init, xs)
    C_in = jnp.moveaxis(C_in, 0, 2)
    n_in = jnp.moveaxis(n_in, 0, 2)
    m_in = jnp.moveaxis(m_in, 0, 2)

    D = b[..., :, None] - b[..., None, :] + li[..., None, :]
    tri = jnp.tril(jnp.ones((L, L), dtype=bool))
    D = jnp.where(tri, D, -jnp.inf)
    inter = b + m_in[..., None]
    m_t = jnp.maximum(inter, jnp.max(D, axis=-1))
    P = jnp.exp(D - m_t[..., None])
    sc = jnp.einsum('bhctd,bhcsd->bhcts', q, k) * P
    scale_in = jnp.exp(inter - m_t)
    num = jnp.einsum('bhcts,bhcsv->bhctv', sc, v) + scale_in[..., None] * jnp.einsum('bhctk,bhckv->bhctv', q, C_in)
    den = jnp.sum(sc, axis=-1) + scale_in * jnp.einsum('bhctk,bhck->bhct', q, n_in)
    h = num / jnp.maximum(jnp.abs(den), jnp.exp(-m_t))[..., None]
    return h.reshape(B, H, S, dv)


def bidirectional_mlstm(q, k, v, o_pre, gate_pre, gate_bias, norm_g):
    B, S, _ = q.shape
    f32 = jnp.float32

    def heads(t):
        return t.astype(f32).reshape(B, S, MLSTM_HEADS, MLSTM_HEAD_DIM).transpose(0, 2, 1, 3)

    qh = heads(q)
    kh = heads(k) * (MLSTM_HEAD_DIM ** -0.5)
    vh = heads(v)
    g = (gate_pre.astype(f32) + gate_bias.astype(f32)).reshape(B, S, 4, MLSTM_HEADS).transpose(2, 0, 3, 1)
    h_fwd = mlstm_chunkwise(qh, kh, vh, g[0], jax.nn.log_sigmoid(g[1]))

    def flip(t):
        return jnp.flip(t, axis=2)

    h_bwd = flip(mlstm_chunkwise(flip(qh), flip(kh), flip(vh), flip(g[2]), jax.nn.log_sigmoid(flip(g[3]))))
    h = h_fwd + h_bwd
    mu = jnp.mean(h, axis=-1, keepdims=True)
    var = jnp.mean(jnp.square(h - mu), axis=-1, keepdims=True)
    h = (h - mu) * lax.rsqrt(var + NORM_EPS)
    h = h.transpose(0, 2, 1, 3).reshape(B, S, MLSTM_WIDTH) * norm_g.astype(f32)
    return (jax.nn.sigmoid(o_pre.astype(f32)) * h).astype(q.dtype)


def setup_inputs(seed: int = 0) -> dict:
    key = jax.random.key(seed)
    ks = jax.random.split(key, 26)
    f32 = jnp.float32
    L = DEPTH

    def dense(k, shape, fan_in):
        return jax.random.normal(k, shape, f32) * (fan_in ** -0.5)

    def gain(k, shape):
        return 1.0 + 0.02 * jax.random.normal(k, shape, f32)

    x = jax.random.normal(ks[0], (BATCH, SEQ, D_MODEL), f32)
    positions = jnp.arange(SEQ, dtype=jnp.int32)[None, :] + jax.random.randint(ks[1], (BATCH, 1), 0, 1024, dtype=jnp.int32)
    forget_base = jnp.linspace(3.0, 6.0, MLSTM_HEADS, dtype=f32)
    is_forget = jnp.array([0.0, 1.0, 0.0, 1.0], f32)
    mlstm_gate_bias = (0.1 * jax.random.normal(ks[8], (L, 4, MLSTM_HEADS), f32) + is_forget[None, :, None] * forget_base[None, None, :]).reshape(L, MLSTM_N_GATES)
    return {
        'x': x,
        'positions': positions,
        'ffn1_norm': gain(ks[2], (L, D_MODEL)),
        'ffn1_w_gate': dense(ks[3], (L, D_MODEL, D_FF), D_MODEL),
        'ffn1_w_up': dense(ks[4], (L, D_MODEL, D_FF), D_MODEL),
        'ffn1_w_down': dense(ks[5], (L, D_FF, D_MODEL), D_FF),
        'mix_norm': gain(ks[6], (L, D_MODEL)),
        'w_in': dense(ks[7], (L, D_MODEL, IN_WIDTH), D_MODEL),
        'mlstm_gate_bias': mlstm_gate_bias,
        'attn_q_norm': gain(ks[9], (L, ATT_HEAD_DIM)),
        'attn_k_norm': gain(ks[10], (L, ATT_HEAD_DIM)),
        'attn_sink': 0.5 * jax.random.normal(ks[11], (L, ATT_HEADS), f32),
        'mlstm_conv_w': dense(ks[12], (L, CONV_K, 2 * MLSTM_WIDTH), CONV_K),
        'mlstm_conv_b': 0.02 * jax.random.normal(ks[13], (L, 2 * MLSTM_WIDTH), f32),
        'mlstm_out_norm': gain(ks[14], (L, MLSTM_WIDTH)),
        'w_branch_attn': dense(ks[15], (L, ATT_WIDTH, D_MODEL), ATT_WIDTH),
        'w_branch_mlstm': dense(ks[16], (L, MLSTM_WIDTH, D_MODEL), MLSTM_WIDTH),
        'w_out': dense(ks[17], (L, D_MODEL, D_MODEL), D_MODEL),
        'ffn2_norm': gain(ks[18], (L, D_MODEL)),
        'ffn2_w_gate': dense(ks[19], (L, D_MODEL, D_FF), D_MODEL),
        'ffn2_w_up': dense(ks[20], (L, D_MODEL, D_FF), D_MODEL),
        'ffn2_w_down': dense(ks[21], (L, D_FF, D_MODEL), D_FF),
        'block_out_norm': gain(ks[22], (L, D_MODEL)),
    }


def reference(x, positions, ffn1_norm, ffn1_w_gate, ffn1_w_up, ffn1_w_down, mix_norm, w_in, mlstm_gate_bias, attn_q_norm, attn_k_norm, attn_sink, mlstm_conv_w, mlstm_conv_b, mlstm_out_norm, w_branch_attn, w_branch_mlstm, w_out, ffn2_norm, ffn2_w_gate, ffn2_w_up, ffn2_w_down, block_out_norm):
    B, S, _ = x.shape
    split_idx = np.cumsum(SPLIT_SIZES)[:-1].tolist()
    for l in range(DEPTH):
        x = x + 0.5 * swiglu(rms_norm(x, ffn1_norm[l]), ffn1_w_gate[l], ffn1_w_up[l], ffn1_w_down[l])

        h = rms_norm(x, mix_norm[l])
        proj = h @ w_in[l]
        qa, ka, va, qm, km, vm, om, gm, gmerge = jnp.split(proj, split_idx, axis=-1)

        qa = rms_norm(qa.reshape(B, S, ATT_HEADS, ATT_HEAD_DIM), attn_q_norm[l])
        ka = rms_norm(ka.reshape(B, S, ATT_KV_HEADS, ATT_HEAD_DIM), attn_k_norm[l])
        qa = partial_rope(qa, positions)
        ka = partial_rope(ka, positions)
        va = va.reshape(B, S, ATT_KV_HEADS, ATT_HEAD_DIM)
        y_a = windowed_gqa_with_sink(qa, ka, va, attn_sink[l])

        qk = jax.nn.silu(centred_depthwise_conv(jnp.concatenate([qm, km], axis=-1), mlstm_conv_w[l], mlstm_conv_b[l]))
        qm, km = jnp.split(qk, 2, axis=-1)
        y_m = bidirectional_mlstm(qm, km, vm, om, gm, mlstm_gate_bias[l], mlstm_out_norm[l])

        g_a, g_m = jnp.split(jax.nn.sigmoid(gmerge), 2, axis=-1)
        merged = g_a * (y_a @ w_branch_attn[l]) + g_m * (y_m @ w_branch_mlstm[l])
        x = x + merged @ w_out[l]

        x = x + 0.5 * swiglu(rms_norm(x, ffn2_norm[l]), ffn2_w_gate[l], ffn2_w_up[l], ffn2_w_down[l])
        x = rms_norm(x, block_out_norm[l])
    return x
```

```cpp
#include <hip/hip_runtime.h>
#include <hip/hip_cooperative_groups.h>
#include <cstdio>
#include <cstdint>
namespace cg = cooperative_groups;
#define SHX(v, m, ln) __int_as_float(__builtin_amdgcn_ds_bpermute((((ln) ^ (m)) << 2), __float_as_int(v)))
namespace pg8 {
#define PG8_LAS __attribute__((address_space(3)))
typedef unsigned short bf16_t;
typedef short bf16x8 __attribute__((ext_vector_type(8)));
typedef float f32x4 __attribute__((ext_vector_type(4)));
typedef unsigned u32x4 __attribute__((ext_vector_type(4)));
constexpr int BM = 256, BK = 64, HALF = 128, HTB = HALF * BK * 2  , STAGE_BYTES = 8 * HTB, NXCD = 8, WGM = 4;

__host__ __device__ __forceinline__ int lds_byte(int r, int c) { const int st = (r >> 4) * 2 + (c >> 5), rr = r & 15, cc = c & 31, ob = rr * 64 + cc * 2; return st * 1024 + (ob ^ (((ob >> 9) & 1) << 5)); }
__host__ __device__ __forceinline__ void stage_rc(int b, int& R, int& C) { const int st = b / 1024, sb = b % 1024, swz = sb ^ (((sb >> 9) & 1) << 5); R = (st >> 1) * 16 + swz / 64; C = (st & 1) * 32 + (swz % 64) / 2; }
__host__ __device__ __forceinline__ int perm32(int rho) { const int n = rho >> 4, i = rho & 15; return 8 * (i >> 2) + 4 * n + (i & 3); }

struct Unit { int pm, pn; };
struct Gemm { const bf16_t* A; const bf16_t* Bt; int M, N, K; };

struct StaticOrder {
    int nM, nN, nwg, G, c;
    __host__ __device__ void init(int M, int N, int G_, int c_) { nM = M / BM; nN = N / BM; nwg = nM * nN; G = G_; c = c_; }
    __host__ __device__ bool next(int i, Unit& u) const {
        const long L = (long)i * G + c; if (L >= nwg) return false;
        int wgid = (int)L; { const int q = nwg / NXCD, r = nwg % NXCD, xcd = wgid % NXCD, off = wgid / NXCD; wgid = (xcd < r ? xcd * (q + 1) : r * (q + 1) + (xcd - r) * q) + off; }
        const int nig = WGM * nN, gid = wgid / nig, fm = gid * WGM, gsz = (nM - fm) < WGM ? (nM - fm) : WGM;
        u.pm = fm + ((wgid % nig) % gsz); u.pn = (wgid % nig) / gsz; return true;
    }
    __device__ __forceinline__ void a_ready(const Unit&) const {}
    __device__ __forceinline__ void done(const Unit&) const {}
};

__device__ __forceinline__ unsigned cvt_pk_bf16(float lo, float hi) { unsigned r; asm volatile("v_cvt_pk_bf16_f32 %0, %1, %2" : "=v"(r) : "v"(lo), "v"(hi)); return r; }
typedef unsigned u32x2 __attribute__((ext_vector_type(2)));
__device__ __forceinline__ float sigm(float x) { return __builtin_amdgcn_rcpf(1.0f + __builtin_amdgcn_exp2f(-1.4426950408889634f * x)); }
__device__ __forceinline__ float bflo(unsigned w) { return __uint_as_float(w << 16); }
__device__ __forceinline__ float bfhi(unsigned w) { return __uint_as_float(w & 0xffff0000u); }
struct EpiSwiGLU { static constexpr bool PERM = true, AFTER_DRAIN = false;
    bf16_t* O; int ldo;
    __device__ __forceinline__ void operator()(const f32x4 (&acc)[2][2][4][2], const Unit& u, int wr, int wc, int fr, int fq) const {
        const int row0 = u.pm * BM + wr * 64 + fr, hc0 = u.pn * 128 + wc * 32 + 8 * fq;
#pragma unroll
        for (int ai = 0; ai < 2; ++ai)
#pragma unroll
            for (int m = 0; m < 4; ++m) { bf16_t* rowp = O + (size_t)(row0 + ai * HALF + m * 16) * ldo + hc0; float h[8];
#pragma unroll
                for (int n = 0; n < 2; ++n) { const f32x4 g = acc[ai][0][m][n], up = acc[ai][1][m][n];
#pragma unroll
                    for (int i = 0; i < 4; ++i) h[4 * n + i] = g[i] * sigm(g[i]) * up[i]; }
                u32x4 w; w.x = cvt_pk_bf16(h[0], h[1]); w.y = cvt_pk_bf16(h[2], h[3]); w.z = cvt_pk_bf16(h[4], h[5]); w.w = cvt_pk_bf16(h[6], h[7]); *(u32x4*)rowp = w; }
    }
};
struct EpiResid { static constexpr bool PERM = true, AFTER_DRAIN = false;
    const float* Xs; float* X; float s;
    __device__ __forceinline__ void operator()(const f32x4 (&acc)[2][2][4][2], const Unit& u, int wr, int wc, int fr, int fq) const {
        const int row0 = u.pm * BM + wr * 64 + fr, col0 = u.pn * BM + wc * 32 + 8 * fq;
#pragma unroll
        for (int ai = 0; ai < 2; ++ai)
#pragma unroll
        for (int mb = 0; mb < 4; mb += 2) { f32x4 xa[2][2][2];
#pragma unroll
            for (int mi = 0; mi < 2; ++mi) { const float* rows = Xs + (size_t)(row0 + ai * HALF + (mb + mi) * 16) * 1024 + col0;
#pragma unroll
                for (int bj = 0; bj < 2; ++bj) { const f32x4* ps = (const f32x4*)(rows + bj * HALF); xa[mi][bj][0] = ps[0]; xa[mi][bj][1] = ps[1]; } }
#pragma unroll
            for (int mi = 0; mi < 2; ++mi) { const int m = mb + mi; float* rowp = X + (size_t)(row0 + ai * HALF + m * 16) * 1024 + col0;
#pragma unroll
                for (int bj = 0; bj < 2; ++bj) { f32x4* p = (f32x4*)(rowp + bj * HALF); p[0] = xa[mi][bj][0] + acc[ai][bj][m][0] * s; p[1] = xa[mi][bj][1] + acc[ai][bj][m][1] * s; } }
            asm volatile("" ::: "memory"); }
    }
};
struct EpiStore { static constexpr bool PERM = true, AFTER_DRAIN = false;
    bf16_t* O0; int ld0, nt0; bf16_t* O1; int ld1;
    __device__ __forceinline__ void operator()(const f32x4 (&acc)[2][2][4][2], const Unit& u, int wr, int wc, int fr, int fq) const {
        const int row0 = u.pm * BM + wr * 64 + fr; bf16_t* base; int ld, colt;
        if (u.pn < nt0) { base = O0; ld = ld0; colt = u.pn * BM; } else { base = O1; ld = ld1; colt = (u.pn - nt0) * BM; }
        const int col0 = colt + wc * 32 + 8 * fq;
#pragma unroll
        for (int ai = 0; ai < 2; ++ai)
#pragma unroll
            for (int m = 0; m < 4; ++m) { bf16_t* rowp = base + (size_t)(row0 + ai * HALF + m * 16) * ld + col0;
#pragma unroll
                for (int bj = 0; bj < 2; ++bj) { const f32x4 v0 = acc[ai][bj][m][0], v1 = acc[ai][bj][m][1]; u32x4 w; w.x = cvt_pk_bf16(v0[0], v0[1]); w.y = cvt_pk_bf16(v0[2], v0[3]); w.z = cvt_pk_bf16(v1[0], v1[1]); w.w = cvt_pk_bf16(v1[2], v1[3]);
                    *(u32x4*)(rowp + bj * HALF) = w; } }
    }
};
template <int MODE> struct EpiGate { static constexpr bool PERM = true, AFTER_DRAIN = false;
    bf16_t* Z; const bf16_t* ZM;
    __device__ __forceinline__ void operator()(const f32x4 (&acc)[2][2][4][2], const Unit& u, int wr, int wc, int fr, int fq) const {
        const int row0 = u.pm * BM + wr * 64 + fr, col0 = u.pn * BM + wc * 32 + 8 * fq;
        constexpr int NB = (MODE == 0) ? 2 : 1;
#pragma unroll
        for (int ai = 0; ai < 2; ++ai)
#pragma unroll
        for (int mb = 0; mb < 4; mb += NB) { u32x4 zz[NB][2], yy[NB][2];
#pragma unroll
            for (int mi = 0; mi < NB; ++mi) { const size_t off = (size_t)(row0 + ai * HALF + (mb + mi) * 16) * 1024 + col0;
#pragma unroll
                for (int bj = 0; bj < 2; ++bj) { zz[mi][bj] = *(const u32x4*)(Z + off + bj * HALF); if (MODE == 1) yy[mi][bj] = *(const u32x4*)(ZM + off + bj * HALF); } }
#pragma unroll
            for (int mi = 0; mi < NB; ++mi) { const int m = mb + mi; const size_t off = (size_t)(row0 + ai * HALF + m * 16) * 1024 + col0;
#pragma unroll
                for (int bj = 0; bj < 2; ++bj) { const f32x4 v0 = acc[ai][bj][m][0], v1 = acc[ai][bj][m][1];
                    const u32x4 z = zz[mi][bj]; float zf[8] = {bflo(z.x), bfhi(z.x), bflo(z.y), bfhi(z.y), bflo(z.z), bfhi(z.z), bflo(z.w), bfhi(z.w)};
                    float o[8];
                    if (MODE == 0) {
#pragma unroll
                        for (int i = 0; i < 4; ++i) { o[i] = sigm(v0[i]) * zf[i]; o[4 + i] = sigm(v1[i]) * zf[4 + i]; }
                    } else { const u32x4 y = yy[mi][bj]; float yf[8] = {bflo(y.x), bfhi(y.x), bflo(y.y), bfhi(y.y), bflo(y.z), bfhi(y.z), bflo(y.w), bfhi(y.w)};
#pragma unroll
                        for (int i = 0; i < 4; ++i) { o[i] = zf[i] + sigm(v0[i]) * yf[i]; o[4 + i] = zf[4 + i] + sigm(v1[i]) * yf[4 + i]; }
                    }
                    u32x4 w; w.x = cvt_pk_bf16(o[0], o[1]); w.y = cvt_pk_bf16(o[2], o[3]); w.z = cvt_pk_bf16(o[4], o[5]); w.w = cvt_pk_bf16(o[6], o[7]);
                    *(u32x4*)(Z + off + bj * HALF) = w; } }
            asm volatile("" ::: "memory"); }
    }
};
template <class Epi, class Sched, bool ALIGN_EPI = false, bool SP2 = false>
__device__ __forceinline__ void gemm_phase(PG8_LAS unsigned char* lds, const Gemm g, const Sched& S, const Epi& E) {
    int tid_ = threadIdx.x; asm volatile("" : "+v"(tid_)); const int tid = tid_, wid = __builtin_amdgcn_readfirstlane(tid >> 6), lane = tid & 63, wr = wid >> 2, wc = wid & 3, fr = lane & 15, fq = lane >> 4;
    const int K = g.K, nt = K / BK;
    unsigned voffA[2], voffB[2];
#pragma unroll
    for (int i = 0; i < 2; ++i) { int R, C; stage_rc(tid * 16 + i * 8192, R, C); const int Rb = Epi::PERM ? ((R & ~31) + perm32(R & 31)) : R;
        voffA[i] = (unsigned)(R * K + C) * 2u; voffB[i] = (unsigned)(Rb * K + C) * 2u; }
    const size_t kstep = (size_t)(BK * 2);
    const size_t hstep = (size_t)HALF * K * 2;
    const size_t tstep = 2 * hstep;
    const unsigned ldsw = (unsigned)wid * 1024u;
    const int aoff = lds_byte(wr * 64 + fr, fq * 8), boff = lds_byte(wc * 32 + fr, fq * 8);
#define PG8_SA(b, h) (((b) * 2 + (h)) * HTB)
#define PG8_SB(b, h) ((4 + (b) * 2 + (h)) * HTB)
#define PG8_STAGE(bufoff, gbase, voff) do { _Pragma("unroll") for (int _i = 0; _i < 2; ++_i) \
        __builtin_amdgcn_global_load_lds((const unsigned*)((const char*)(gbase) + (voff)[_i]), (PG8_LAS unsigned*)(lds + (bufoff) + ldsw + _i * 8192), 16, 0, 0); } while (0)
#define PG8_LDA(dst, b, h) do { _Pragma("unroll") for (int m = 0; m < 4; ++m) _Pragma("unroll") for (int k = 0; k < 2; ++k) dst[m][k] = *(const PG8_LAS bf16x8*)(lds + PG8_SA(b, h) + aoff + m * 2048 + k * 1024); } while (0)
#define PG8_LDB(dst, b, h) do { _Pragma("unroll") for (int n = 0; n < 2; ++n) _Pragma("unroll") for (int k = 0; k < 2; ++k) dst[n][k] = *(const PG8_LAS bf16x8*)(lds + PG8_SB(b, h) + boff + n * 2048 + k * 1024); } while (0)
#define PG8_MMA(ai, bj, At, Bt) do { __builtin_amdgcn_s_setprio(1); _Pragma("unroll") for (int m = 0; m < 4; ++m) _Pragma("unroll") for (int n = 0; n < 2; ++n) _Pragma("unroll") for (int k = 0; k < 2; ++k) \
        acc[ai][bj][m][n] = __builtin_amdgcn_mfma_f32_16x16x32_bf16(Bt[n][k], At[m][k], acc[ai][bj][m][n], 0, 0, 0); __builtin_amdgcn_s_setprio(0); } while (0)
#define PG8_WAIT_V(n) asm volatile("s_waitcnt vmcnt(" #n ")" ::: "memory")
#define PG8_WAIT_L(n) asm volatile("s_waitcnt lgkmcnt(" #n ")" ::: "memory")
#define PG8_BAR __builtin_amdgcn_s_barrier()
#define PG8_SCHED __builtin_amdgcn_sched_barrier(0)
    Unit cur, nxt; int ui = 0;
    if (!S.next(0, cur)) return;
    f32x4 acc[2][2][4][2];
#pragma unroll
    for (int a = 0; a < 2; ++a)
#pragma unroll
        for (int b = 0; b < 2; ++b)
#pragma unroll
            for (int m = 0; m < 4; ++m)
#pragma unroll
                for (int n = 0; n < 2; ++n) acc[a][b][m][n] = (f32x4){0.f, 0.f, 0.f, 0.f};
    bf16x8 At[4][2], B0[2][2], B1[2][2];
    const char* cA = (const char*)g.A + (size_t)cur.pm * tstep; const char* cB = (const char*)g.Bt + (size_t)cur.pn * tstep;
    S.a_ready(cur);
    if constexpr (SP2) {
        PG8_STAGE(PG8_SB(0, 0), cB, voffB); PG8_STAGE(PG8_SB(0, 1), cB + hstep, voffB); PG8_STAGE(PG8_SA(0, 0), cA, voffA); PG8_STAGE(PG8_SA(0, 1), cA + hstep, voffA);
        if (wr == 1) PG8_BAR;
        PG8_WAIT_V(2); PG8_BAR;
        PG8_STAGE(PG8_SB(1, 0), cB + kstep, voffB); PG8_STAGE(PG8_SA(1, 0), cA + kstep, voffA); PG8_STAGE(PG8_SB(1, 1), cB + hstep + kstep, voffB);
        PG8_WAIT_V(6); PG8_BAR;
    } else {
        PG8_STAGE(PG8_SB(0, 0), cB, voffB); PG8_STAGE(PG8_SA(0, 0), cA, voffA); PG8_STAGE(PG8_SB(0, 1), cB + hstep, voffB); PG8_STAGE(PG8_SA(0, 1), cA + hstep, voffA);
        if (wr == 1) PG8_BAR;
        PG8_WAIT_V(4); PG8_BAR;
        PG8_STAGE(PG8_SB(1, 0), cB + kstep, voffB); PG8_STAGE(PG8_SA(1, 0), cA + kstep, voffA); PG8_STAGE(PG8_SB(1, 1), cB + hstep + kstep, voffB);
        PG8_WAIT_V(6); PG8_BAR;
    }
    for (;;) {
        const bool has_next = S.next(ui + 1, nxt);
        const char* nA = has_next ? (const char*)g.A + (size_t)nxt.pm * tstep : cA; const char* nB = has_next ? (const char*)g.Bt + (size_t)nxt.pn * tstep : cB;
        for (int t = 0; t < nt; t += 2) {
            const bool last = (t == nt - 2);
            const char* a1 = cA + (size_t)(t + 1) * kstep;
            const char* a2 = last ? nA : cA + (size_t)(t + 2) * kstep; const char* b2 = last ? nB : cB + (size_t)(t + 2) * kstep;
            const char* a3 = a2 + kstep; const char* b3 = b2 + kstep;
            if (last && has_next) S.a_ready(nxt);
            if constexpr (SP2) {
            PG8_LDB(B0, 0, 0); PG8_LDB(B1, 0, 1); PG8_SCHED; PG8_LDA(At, 0, 0); PG8_STAGE(PG8_SA(1, 1), a1 + hstep, voffA);
            PG8_WAIT_V(8); PG8_WAIT_L(0); PG8_BAR; PG8_MMA(0, 0, At, B0); PG8_MMA(0, 1, At, B1); PG8_BAR; PG8_SCHED;
            PG8_LDA(At, 0, 1); PG8_STAGE(PG8_SB(0, 0), b2, voffB); PG8_STAGE(PG8_SB(0, 1), b2 + hstep, voffB); PG8_STAGE(PG8_SA(0, 0), a2, voffA);
            PG8_WAIT_V(8); PG8_WAIT_L(0); PG8_BAR; PG8_MMA(1, 0, At, B0); PG8_MMA(1, 1, At, B1); PG8_BAR; PG8_SCHED;
            PG8_LDB(B0, 1, 0); PG8_LDB(B1, 1, 1); PG8_SCHED; PG8_LDA(At, 1, 0); PG8_STAGE(PG8_SA(0, 1), a2 + hstep, voffA);
            PG8_WAIT_V(8); PG8_WAIT_L(0); PG8_BAR; PG8_MMA(0, 0, At, B0); PG8_MMA(0, 1, At, B1); PG8_BAR; PG8_SCHED;
            PG8_LDA(At, 1, 1); PG8_STAGE(PG8_SB(1, 0), b3, voffB); PG8_STAGE(PG8_SB(1, 1), b3 + hstep, voffB); PG8_STAGE(PG8_SA(1, 0), a3, voffA);
            PG8_WAIT_V(8); PG8_WAIT_L(0); PG8_BAR; PG8_MMA(1, 0, At, B0); PG8_MMA(1, 1, At, B1); PG8_BAR; PG8_SCHED;
            } else {
            PG8_LDB(B0, 0, 0); PG8_SCHED; PG8_LDA(At, 0, 0); PG8_STAGE(PG8_SA(1, 1), a1 + hstep, voffA);
            PG8_WAIT_L(8); PG8_BAR; PG8_WAIT_L(0); PG8_MMA(0, 0, At, B0); PG8_BAR; PG8_SCHED;
            PG8_LDB(B1, 0, 1); PG8_STAGE(PG8_SB(0, 0), b2, voffB);
            PG8_BAR; PG8_WAIT_L(0); PG8_MMA(0, 1, At, B1); PG8_BAR;
            PG8_LDA(At, 0, 1); PG8_STAGE(PG8_SA(0, 0), a2, voffA);
            PG8_BAR; PG8_WAIT_L(0); PG8_MMA(1, 0, At, B0); PG8_BAR; PG8_SCHED;
            PG8_STAGE(PG8_SB(0, 1), b2 + hstep, voffB);
            PG8_WAIT_V(6); PG8_BAR; PG8_MMA(1, 1, At, B1); PG8_BAR;
            PG8_LDB(B0, 1, 0); PG8_SCHED; PG8_LDA(At, 1, 0); PG8_STAGE(PG8_SA(0, 1), a2 + hstep, voffA);
            PG8_WAIT_L(8); PG8_BAR; PG8_WAIT_L(0); PG8_MMA(0, 0, At, B0); PG8_BAR; PG8_SCHED;
            PG8_LDB(B1, 1, 1); PG8_STAGE(PG8_SB(1, 0), b3, voffB);
            PG8_BAR; PG8_WAIT_L(0); PG8_MMA(0, 1, At, B1); PG8_BAR;
            PG8_LDA(At, 1, 1); PG8_STAGE(PG8_SA(1, 0), a3, voffA);
            PG8_BAR; PG8_WAIT_L(0); PG8_MMA(1, 0, At, B0); PG8_BAR; PG8_SCHED;
            PG8_STAGE(PG8_SB(1, 1), b3 + hstep, voffB);
            PG8_WAIT_V(6); PG8_BAR; PG8_MMA(1, 1, At, B1); PG8_BAR;
            }
        }
        if constexpr (ALIGN_EPI) { if (wr == 0) PG8_BAR; }
        if constexpr (!Epi::AFTER_DRAIN) { E(acc, cur, wr, wc, fr, fq); S.done(cur); }
        if (!has_next) break;
#pragma unroll
        for (int a = 0; a < 2; ++a)
#pragma unroll
            for (int b = 0; b < 2; ++b)
#pragma unroll
                for (int m = 0; m < 4; ++m)
#pragma unroll
                    for (int n = 0; n < 2; ++n) acc[a][b][m][n] = (f32x4){0.f, 0.f, 0.f, 0.f};
        cur = nxt; cA = nA; cB = nB; ++ui;
        if constexpr (ALIGN_EPI) { if (wr == 1) PG8_BAR; }
    }
    PG8_WAIT_V(0);
    if constexpr (!ALIGN_EPI) { if (wr == 0) PG8_BAR; }
    PG8_BAR;
    if constexpr (Epi::AFTER_DRAIN) { E.fused(acc, cur, wr, wc, fr, fq, lds, wid, lane); S.done(cur); }
#undef PG8_SA
#undef PG8_SB
#undef PG8_STAGE
#undef PG8_LDA
#undef PG8_LDB
#undef PG8_MMA
#undef PG8_WAIT_V
#undef PG8_WAIT_L
#undef PG8_BAR
#undef PG8_SCHED
}
}
namespace mk {
#define LAS __attribute__((address_space(3)))
typedef unsigned short bf16_t;
typedef short bf16x8 __attribute__((ext_vector_type(8)));
typedef float f32x4 __attribute__((ext_vector_type(4)));
typedef float f32x16 __attribute__((ext_vector_type(16)));
typedef unsigned u32x4 __attribute__((ext_vector_type(4)));
typedef unsigned u32x2 __attribute__((ext_vector_type(2)));
constexpr int NB = 16, SEQ = 2048, DM = 1024, M = NB * SEQ, FF = 2816, NGU = 2 * FF, NIN = 4864, NINA = 2816, DEPTH = 2, INW = 4880;
constexpr int P1W = 2304;
constexpr float EPS = 1e-6f;
constexpr size_t MiB = 1u << 20;
constexpr size_t WS_ROPE = 1 * MiB;
constexpr size_t WS_GATE = 3 * MiB;
constexpr size_t WS_SLOT = 5 * MiB;
constexpr size_t WS_W = 8 * MiB, W_LAYER = 48 * MiB;
constexpr size_t WO_GU1 = 0, WO_D1 = WO_GU1 + (size_t)NGU * DM * 2, WO_IN = WO_D1 + (size_t)DM * FF * 2, WO_A = WO_IN + (size_t)NIN * DM * 2, WO_B = WO_A + (size_t)DM * 512 * 2,
                 WO_O = WO_B + (size_t)DM * 512 * 2, WO_GU2 = WO_O + (size_t)DM * DM * 2, WO_D2 = WO_GU2 + (size_t)NGU * DM * 2, WO_END = WO_D2 + (size_t)DM * FF * 2;
static_assert(WO_END <= W_LAYER, "weights per layer");
constexpr size_t WS_XN = 104 * MiB;
constexpr size_t WS_P1 = 168 * MiB;
constexpr size_t WS_OM = WS_P1 + 144 * MiB;
constexpr size_t WS_YA = WS_OM + 32 * MiB;
constexpr size_t WS_HF = WS_YA + 32 * MiB;
constexpr size_t WS_HB = WS_HF + 32 * MiB;
constexpr size_t WS_END = WS_HB + 32 * MiB;
constexpr int LDS_BYTES = 147456;
constexpr int NSUB = 12, NPHASE = 1 + NSUB * DEPTH;

__device__ __forceinline__ float bf2f(bf16_t h) { return __uint_as_float(((unsigned)h) << 16); }
__device__ __forceinline__ float bflo(unsigned w) { return __uint_as_float(w << 16); }
__device__ __forceinline__ float bfhi(unsigned w) { return __uint_as_float(w & 0xffff0000u); }
__device__ __forceinline__ unsigned pk2(float lo, float hi) { return pg8::cvt_pk_bf16(lo, hi); }
__device__ __forceinline__ bf16_t f2bf(float f) { return (bf16_t)(pk2(f, 0.f) & 0xffffu); }
__device__ __forceinline__ void unpack8(const u32x4 w, float (&x)[8]) { x[0] = bflo(w.x); x[1] = bfhi(w.x); x[2] = bflo(w.y); x[3] = bfhi(w.y); x[4] = bflo(w.z); x[5] = bfhi(w.z); x[6] = bflo(w.w); x[7] = bfhi(w.w); }
__device__ __forceinline__ u32x4 pack8(const float (&x)[8]) { u32x4 w; w.x = pk2(x[0], x[1]); w.y = pk2(x[2], x[3]); w.z = pk2(x[4], x[5]); w.w = pk2(x[6], x[7]); return w; }
__device__ __forceinline__ float sigm(float x) { return __builtin_amdgcn_rcpf(1.0f + __builtin_amdgcn_exp2f(-1.4426950408889634f * x)); }
__device__ __forceinline__ float wave_sum(float v) {
#pragma unroll
    for (int o = 1; o < 64; o <<= 1) v += __shfl_xor(v, o);
    return v;
}
__device__ __forceinline__ int crow(int r, int hi) { return (r & 3) + 8 * (r >> 2) + 4 * hi; }
__device__ __forceinline__ f32x16 mfma32(bf16x8 a, bf16x8 b, f32x16 c) { return __builtin_amdgcn_mfma_f32_32x32x16_bf16(a, b, c, 0, 0, 0); }
#define LDS_WAIT() asm volatile("s_waitcnt lgkmcnt(0)" ::: "memory")

struct Ctx {
    float* X; unsigned char* ws; LAS unsigned char* lds;
    int tid, lane, wave, G, bid;
};

template <int MODE> __device__ __forceinline__ void transpose_item(const float* src0, const float* src1, int K, int Nsrc, bf16_t* WT, LAS float* scr, int item, int nblk, int lane) {
    const int kb = item / nblk, nb = item % nblk, k0 = 64 * kb, n0 = 32 * nb;
    const int np = n0 + (lane & 31); const float* src = src0; int col = np;
    if (MODE == 1) { const int rr = np & 255; src = (rr & 128) ? src1 : src0; col = 128 * (np >> 8) + (rr & 127); }
    if (MODE == 2) { col = np < NINA ? np : np + 16; }
    float tv[32];
#pragma unroll
    for (int i = 0; i < 32; ++i) { const int kk = 2 * i + (lane >> 5); tv[i] = src[(size_t)(k0 + kk) * Nsrc + col]; }
#pragma unroll
    for (int i = 0; i < 32; ++i) { const int kk = 2 * i + (lane >> 5); scr[kk * 33 + (lane & 31)] = tv[i]; }
    LDS_WAIT();
    const int c = lane & 7;
#pragma unroll
    for (int j = 0; j < 4; ++j) { const int n = (lane >> 3) + 8 * j; const LAS float* s = scr + (8 * c) * 33 + n;
        u32x4 o; o.x = pk2(s[0 * 33], s[1 * 33]); o.y = pk2(s[2 * 33], s[3 * 33]); o.z = pk2(s[4 * 33], s[5 * 33]); o.w = pk2(s[6 * 33], s[7 * 33]);
        *(u32x4*)(WT + (size_t)(n0 + n) * K + k0 + 8 * c) = o; }
    LDS_WAIT();
}
__device__ __forceinline__ void prologue_weights(const Ctx& C, const float* w3, const float* w4, const float* w5, const float* w7, const float* w15, const float* w16, const float* w17, const float* w19, const float* w20, const float* w21) {
    LAS float* scr = (LAS float*)(C.lds + C.wave * 8704);
    const int gw = C.bid * 8 + C.wave, NGW = C.G * 8;
    constexpr int I_GU = 16 * (NGU / 32), I_D = (FF / 64) * (DM / 32), I_IN = 16 * (NIN / 32), I_AB = 8 * (DM / 32), I_O = 16 * (DM / 32);
    constexpr int PER = 2 * I_GU + 2 * I_D + I_IN + 2 * I_AB + I_O;
    for (int it = gw; it < DEPTH * PER; it += NGW) {
        const int l = it / PER; int r = it % PER; bf16_t* wl = (bf16_t*)(C.ws + WS_W + (size_t)l * W_LAYER);
        if (r < I_GU) { transpose_item<1>(w3 + (size_t)l * DM * FF, w4 + (size_t)l * DM * FF, DM, FF, (bf16_t*)((unsigned char*)wl + WO_GU1), scr, r, NGU / 32, C.lane); continue; } r -= I_GU;
        if (r < I_D) { transpose_item<0>(w5 + (size_t)l * FF * DM, nullptr, FF, DM, (bf16_t*)((unsigned char*)wl + WO_D1), scr, r, DM / 32, C.lane); continue; } r -= I_D;
        if (r < I_IN) { transpose_item<2>(w7 + (size_t)l * DM * INW, nullptr, DM, INW, (bf16_t*)((unsigned char*)wl + WO_IN), scr, r, NIN / 32, C.lane); continue; } r -= I_IN;
        if (r < I_AB) { transpose_item<0>(w15 + (size_t)l * 512 * DM, nullptr, 512, DM, (bf16_t*)((unsigned char*)wl + WO_A), scr, r, DM / 32, C.lane); continue; } r -= I_AB;
        if (r < I_AB) { transpose_item<0>(w16 + (size_t)l * 512 * DM, nullptr, 512, DM, (bf16_t*)((unsigned char*)wl + WO_B), scr, r, DM / 32, C.lane); continue; } r -= I_AB;
        if (r < I_O) { transpose_item<0>(w17 + (size_t)l * DM * DM, nullptr, DM, DM, (bf16_t*)((unsigned char*)wl + WO_O), scr, r, DM / 32, C.lane); continue; } r -= I_O;
        if (r < I_GU) { transpose_item<1>(w19 + (size_t)l * DM * FF, w20 + (size_t)l * DM * FF, DM, FF, (bf16_t*)((unsigned char*)wl + WO_GU2), scr, r, NGU / 32, C.lane); continue; } r -= I_GU;
        transpose_item<0>(w21 + (size_t)l * FF * DM, nullptr, FF, DM, (bf16_t*)((unsigned char*)wl + WO_D2), scr, r, DM / 32, C.lane);
    }
}
__device__ __forceinline__ void prologue_rope(const Ctx& C, const int* pos) {
 float* rope = (float*)(C.ws + WS_ROPE);
    const float invf[8] = {1.0f, 0.19392274474868576f, 0.03760603093086393f, 0.007292664737217109f, 0.001414213562373095f, 0.0002742481756762073f, 5.318295896944988e-05f, 1.031338537721246e-05f};
    for (int idx = C.bid * 512 + C.tid; idx < M * 8; idx += C.G * 512) {
        const int tok = idx >> 3, i = idx & 7; float f = invf[0];
#pragma unroll
        for (int q = 1; q < 8; ++q) f = (i == q) ? invf[q] : f;
        const float ang = (float)pos[tok] * f;
        const double rev = (double)ang * 0.15915494309189535; const float fr = (float)(rev - floor(rev));
        rope[tok * 16 + i] = __builtin_amdgcn_cosf(fr); rope[tok * 16 + 8 + i] = __builtin_amdgcn_sinf(fr);
    }
}
template <int MODE> __device__ __forceinline__ void norm_pass(const Ctx& C, const float* src, const float* g0, const float* g1, const float* win_l, const float* gbias) {
    bf16_t* XN = (bf16_t*)(C.ws + WS_XN); float* gates = (float*)(C.ws + WS_GATE);
    const bool xl = (C.G == 256); const int lane = C.lane;
    const int gw = xl ? 4096 * (C.bid & 7) + ((C.bid >> 3) * 8 + C.wave) * 16 : C.bid * 8 + C.wave, NGW = xl ? 1 : C.G * 8, rend = xl ? gw + 16 : M;
    LAS float* Wg = (LAS float*)C.lds;
    if (MODE == 1) {
        for (int idx = C.tid; idx < 1024 * 16; idx += 512) { const int k = idx >> 4, g = idx & 15; const int lp = (k & 255) >> 2, i = k & 3, j = k >> 8;
            Wg[(((j * 4 + i) * 64) + lp) * 20 + g] = win_l[(size_t)k * INW + NINA + g]; }
        __syncthreads();
    }
    f32x4 gv[4];
#pragma unroll
    for (int j = 0; j < 4; ++j) gv[j] = ((const f32x4*)g0)[lane + 64 * j];
    f32x4 nv[4];
    if (gw < rend) { const f32x4* xr0 = (const f32x4*)(src + (size_t)gw * DM) + lane;
#pragma unroll
        for (int j = 0; j < 4; ++j) nv[j] = xr0[64 * j]; }
    for (int row = gw; row < rend; row += NGW) {
        f32x4 v[4]; float ss = 0.f;
#pragma unroll
        for (int j = 0; j < 4; ++j) v[j] = nv[j];
        if (row + NGW < rend) { const f32x4* xr1 = (const f32x4*)(src + (size_t)(row + NGW) * DM) + lane;
#pragma unroll
            for (int j = 0; j < 4; ++j) nv[j] = xr1[64 * j]; }
#pragma unroll
        for (int j = 0; j < 4; ++j) ss += (v[j].x * v[j].x + v[j].y * v[j].y) + (v[j].z * v[j].z + v[j].w * v[j].w);
        const float rstd = rsqrtf(wave_sum(ss) * (1.0f / DM) + EPS);
#pragma unroll
        for (int j = 0; j < 4; ++j) v[j] = v[j] * rstd * gv[j];
        if (MODE == 3) {
            f32x4* xo = (f32x4*)(C.X + (size_t)row * DM) + lane;
#pragma unroll
            for (int j = 0; j < 4; ++j) xo[64 * j] = v[j];
            if (g1 == nullptr) continue;
            float s2 = 0.f;
#pragma unroll
            for (int j = 0; j < 4; ++j) s2 += (v[j].x * v[j].x + v[j].y * v[j].y) + (v[j].z * v[j].z + v[j].w * v[j].w);
            const float r2 = rsqrtf(wave_sum(s2) * (1.0f / DM) + EPS);
#pragma unroll
            for (int j = 0; j < 4; ++j) v[j] = v[j] * r2 * ((const f32x4*)g1)[lane + 64 * j];
        }
        u32x2* o8 = (u32x2*)(XN + (size_t)row * DM) + lane;
#pragma unroll
        for (int j = 0; j < 4; ++j) { u32x2 w; w.x = pk2(v[j].x, v[j].y); w.y = pk2(v[j].z, v[j].w); o8[64 * j] = w; }
        if (MODE == 1) {
            float ga[16];
#pragma unroll
            for (int g = 0; g < 16; ++g) ga[g] = 0.f;
#pragma unroll
            for (int j = 0; j < 4; ++j)
#pragma unroll
                for (int i = 0; i < 4; ++i) { const float xv = v[j][i]; const LAS f32x4* wp = (const LAS f32x4*)(Wg + (((j * 4 + i) * 64) + lane) * 20);
#pragma unroll
                    for (int q = 0; q < 4; ++q) { const f32x4 w = wp[q]; ga[4 * q] += xv * w.x; ga[4 * q + 1] += xv * w.y; ga[4 * q + 2] += xv * w.z; ga[4 * q + 3] += xv * w.w; } }
            const bool b5 = (lane & 32) != 0, b4 = (lane & 16) != 0, b3 = (lane & 8) != 0, b2 = (lane & 4) != 0;
            float g8[8], g4[4], g2[2];
#pragma unroll
            for (int i = 0; i < 8; ++i) { const float mine = b5 ? ga[8 + i] : ga[i], oth = b5 ? ga[i] : ga[8 + i]; g8[i] = mine + __shfl_xor(oth, 32); }
#pragma unroll
            for (int i = 0; i < 4; ++i) { const float mine = b4 ? g8[4 + i] : g8[i], oth = b4 ? g8[i] : g8[4 + i]; g4[i] = mine + __shfl_xor(oth, 16); }
#pragma unroll
            for (int i = 0; i < 2; ++i) { const float mine = b3 ? g4[2 + i] : g4[i], oth = b3 ? g4[i] : g4[2 + i]; g2[i] = mine + __shfl_xor(oth, 8); }
            float g1 = (b2 ? g2[1] : g2[0]) + __shfl_xor(b2 ? g2[0] : g2[1], 4);
            g1 += __shfl_xor(g1, 2); g1 += __shfl_xor(g1, 1);
            if ((lane & 3) == 0) { const int g = (b5 ? 8 : 0) + (b4 ? 4 : 0) + (b3 ? 2 : 0) + (b2 ? 1 : 0); gates[(size_t)row * 16 + g] = g1 + gbias[g]; }
        }
    }
}
__device__ __forceinline__ void mc_pass(const Ctx& C, const float* ng) {
    bf16_t* HF = (bf16_t*)(C.ws + WS_HF); const bf16_t* HB = (const bf16_t*)(C.ws + WS_HB); const bf16_t* OM = (const bf16_t*)(C.ws + WS_OM);
    const bool xl = (C.G == 256); const int lane = C.lane;
    const int gw = xl ? 4096 * (C.bid & 7) + ((C.bid >> 3) * 8 + C.wave) * 16 : C.bid * 8 + C.wave, NGW = xl ? 1 : C.G * 8, rend = xl ? gw + 16 : M;
    const f32x4 g0 = ((const f32x4*)ng)[2 * lane], g1 = ((const f32x4*)ng)[2 * lane + 1];
    const float gg[8] = {g0.x, g0.y, g0.z, g0.w, g1.x, g1.y, g1.z, g1.w};
    for (int row = gw; row < rend; row += NGW) {
        const size_t off = (size_t)row * 512 + 8 * lane;
        float a[8], b[8], o[8]; unpack8(*(const u32x4*)(HF + off), a); unpack8(*(const u32x4*)(HB + off), b); unpack8(*(const u32x4*)(OM + off), o);
        float s = 0.f;
#pragma unroll
        for (int i = 0; i < 8; ++i) { a[i] += b[i]; s += a[i]; }
        s += __shfl_xor(s, 1); s += __shfl_xor(s, 2); s += __shfl_xor(s, 4); s += __shfl_xor(s, 8);
        const float mu = s * (1.0f / 128.0f); float q = 0.f;
#pragma unroll
        for (int i = 0; i < 8; ++i) { a[i] -= mu; q += a[i] * a[i]; }
        q += __shfl_xor(q, 1); q += __shfl_xor(q, 2); q += __shfl_xor(q, 4); q += __shfl_xor(q, 8);
        const float rs = rsqrtf(q * (1.0f / 128.0f) + EPS);
#pragma unroll
        for (int i = 0; i < 8; ++i) a[i] = a[i] * rs * gg[i] * sigm(o[i]);
        *(u32x4*)(HF + off) = pack8(a);
    }
}
constexpr int AT_KROW = 144, AT_VROW = 776, AT_K_OFF = 0, AT_V_OFF = 384 * AT_KROW, AT_END = AT_V_OFF + 64 * AT_VROW;
static_assert(AT_END <= LDS_BYTES, "attention LDS");
__device__ __forceinline__ void attn_unit(const Ctx& C, int unit, const float* gq, const float* gk, const float* sink) {
    const bf16_t* P1 = (const bf16_t*)(C.ws + WS_P1); const float* rope = (const float*)(C.ws + WS_ROPE); bf16_t* YA = (bf16_t*)(C.ws + WS_YA);
    LAS unsigned char* lds = C.lds; const int tid = C.tid, lane = C.lane, wave = C.wave, hi = lane >> 5, l31 = lane & 31;
    const int b = unit >> 5, kvh = (unit >> 4) & 1, n = unit & 15;
    const size_t tokb = (size_t)b * SEQ; const int kpos0 = (n - 1) * 128;
    {
        const int p = tid & 7;
        const f32x4 ga = ((const f32x4*)gk)[2 * p], gb = ((const f32x4*)gk)[2 * p + 1];
        const float gkk[8] = {ga.x, ga.y, ga.z, ga.w, gb.x, gb.y, gb.z, gb.w};
#pragma unroll 2
        for (int it = 0; it < 6; ++it) {
            const int j = (tid >> 3) + 64 * it; const int kp = kpos0 + j; const bool ok = (kp >= 0) && (kp < SEQ);
            u32x4 kraw = (u32x4){0u, 0u, 0u, 0u}, vraw = (u32x4){0u, 0u, 0u, 0u}; f32x4 c0 = (f32x4){0.f, 0.f, 0.f, 0.f}, c1 = c0, s0 = c0, s1 = c0;
            if (ok) { const bf16_t* rp = P1 + (tokb + kp) * P1W; kraw = *(const u32x4*)(rp + 512 + kvh * 64 + p * 8); vraw = *(const u32x4*)(rp + 640 + kvh * 64 + p * 8);
                if (p < 2) { const f32x4* rt = (const f32x4*)(rope + (tokb + kp) * 16); c0 = rt[0]; c1 = rt[1]; s0 = rt[2]; s1 = rt[3]; } }
            float x[8]; unpack8(kraw, x); float ss = 0.f;
#pragma unroll
            for (int i = 0; i < 8; ++i) ss += x[i] * x[i];
            ss += SHX(ss, 1, lane); ss += SHX(ss, 2, lane); ss += SHX(ss, 4, lane);
            const float rstd = rsqrtf(ss * (1.0f / 64.0f) + EPS);
            const float cs[8] = {c0.x, c0.y, c0.z, c0.w, c1.x, c1.y, c1.z, c1.w}, sn[8] = {s0.x, s0.y, s0.z, s0.w, s1.x, s1.y, s1.z, s1.w};
#pragma unroll
            for (int i = 0; i < 8; ++i) { const float y = x[i] * rstd * gkk[i]; const float pr = SHX(y, 1, lane);
                x[i] = (p == 0) ? (y * cs[i] - pr * sn[i]) : ((p == 1) ? (y * cs[i] + pr * sn[i]) : y); }
            *(LAS u32x4*)(lds + AT_K_OFF + j * AT_KROW + p * 16) = pack8(x);
            const unsigned vw[4] = {vraw.x, vraw.y, vraw.z, vraw.w};
#pragma unroll
            for (int i = 0; i < 8; ++i) { const bf16_t e = (bf16_t)((i & 1) ? (vw[i >> 1] >> 16) : (vw[i >> 1] & 0xffffu)); *(LAS bf16_t*)(lds + AT_V_OFF + (p * 8 + i) * AT_VROW + j * 2) = e; }
        }
    }
    __syncthreads();
    const int g = wave >> 1, hq = kvh * 4 + g;
    const float sinkL = sink[hq] * 1.4426950408889634f;
    const int jlo = (n == 0) ? 128 : 0, jhi = (n == 15) ? 256 : 384;
    for (int sub = 0; sub < 2; ++sub) {
        const int q0 = (wave & 1) * 64 + sub * 32, qi = q0 + l31; const size_t tq = tokb + n * 128 + qi;
        bf16x8 qf[4];
        {
            float x[4][8]; float ss = 0.f; const bf16_t* rp = P1 + tq * P1W + hq * 64 + 8 * hi;
#pragma unroll
            for (int ks = 0; ks < 4; ++ks) { unpack8(*(const u32x4*)(rp + 16 * ks), x[ks]);
#pragma unroll
                for (int i = 0; i < 8; ++i) ss += x[ks][i] * x[ks][i]; }
            ss += SHX(ss, 32, lane);
            const float rstd = rsqrtf(ss * (1.0f / 64.0f) + EPS);
            const f32x4* rt = (const f32x4*)(rope + tq * 16); const f32x4 c0 = rt[0], c1 = rt[1], s0 = rt[2], s1 = rt[3];
            const float cs[8] = {c0.x, c0.y, c0.z, c0.w, c1.x, c1.y, c1.z, c1.w}, sn[8] = {s0.x, s0.y, s0.z, s0.w, s1.x, s1.y, s1.z, s1.w};
            constexpr float QS = 0.125f * 1.4426950408889634f;
#pragma unroll
            for (int ks = 0; ks < 4; ++ks) { const f32x4 ga = *(const f32x4*)(gq + 16 * ks + 8 * hi), gb = *(const f32x4*)(gq + 16 * ks + 8 * hi + 4);
                const float gg[8] = {ga.x, ga.y, ga.z, ga.w, gb.x, gb.y, gb.z, gb.w};
#pragma unroll
                for (int i = 0; i < 8; ++i) x[ks][i] = x[ks][i] * rstd * gg[i]; }
#pragma unroll
            for (int i = 0; i < 8; ++i) { const float y = x[0][i]; const float pr = SHX(y, 32, lane); x[0][i] = (hi == 0) ? (y * cs[i] - pr * sn[i]) : (y * cs[i] + pr * sn[i]); }
#pragma unroll
            for (int ks = 0; ks < 4; ++ks) {
#pragma unroll
                for (int i = 0; i < 8; ++i) x[ks][i] *= QS;
                qf[ks] = __builtin_bit_cast(bf16x8, pack8(x[ks])); }
        }
        float mrun = sinkL, lsum = 0.f; f32x16 o0, o1;
#pragma unroll
        for (int r = 0; r < 16; ++r) { o0[r] = 0.f; o1[r] = 0.f; }
        for (int t = 0; t < 6; ++t) {
            const int j0 = 64 * t;
            if (j0 + 63 < q0 || j0 > q0 + 31 + 256 || j0 + 63 < jlo || j0 >= jhi) continue;
            f32x16 p0, p1;
#pragma unroll
            for (int r = 0; r < 16; ++r) { p0[r] = 0.f; p1[r] = 0.f; }
#pragma unroll
            for (int ks = 0; ks < 4; ++ks) {
                const bf16x8 a0 = *(const LAS bf16x8*)(lds + AT_K_OFF + (j0 + l31) * AT_KROW + (16 * ks + 8 * hi) * 2);
                const bf16x8 a1 = *(const LAS bf16x8*)(lds + AT_K_OFF + (j0 + 32 + l31) * AT_KROW + (16 * ks + 8 * hi) * 2);
                p0 = mfma32(a0, qf[ks], p0); p1 = mfma32(a1, qf[ks], p1);
            }
            float mx = -INFINITY;
            const bool interior = (j0 >= jlo) && (j0 + 64 <= jhi) && (j0 >= q0 + 31) && (j0 + 63 <= q0 + 256);
            if (interior) {
#pragma unroll
                for (int r = 0; r < 16; ++r) mx = fmaxf(mx, fmaxf(p0[r], p1[r]));
            } else {
#pragma unroll
                for (int r = 0; r < 16; ++r) { const int ja = j0 + crow(r, hi), jb = ja + 32;
                    const bool va = (ja >= qi) && (ja <= qi + 256) && (ja >= jlo) && (ja < jhi), vb = (jb >= qi) && (jb <= qi + 256) && (jb >= jlo) && (jb < jhi);
                    p0[r] = va ? p0[r] : -INFINITY; p1[r] = vb ? p1[r] : -INFINITY; mx = fmaxf(mx, fmaxf(p0[r], p1[r])); }
            }
            mx = fmaxf(mx, SHX(mx, 32, lane));
            const float mnew = fmaxf(mrun, mx), alpha = __builtin_amdgcn_exp2f(mrun - mnew); mrun = mnew;
            float ps = 0.f;
#pragma unroll
            for (int r = 0; r < 16; ++r) { p0[r] = __builtin_amdgcn_exp2f(p0[r] - mnew); p1[r] = __builtin_amdgcn_exp2f(p1[r] - mnew); ps += p0[r] + p1[r]; }
            lsum = lsum * alpha + ps;
#pragma unroll
            for (int r = 0; r < 16; ++r) { o0[r] *= alpha; o1[r] *= alpha; }
#pragma unroll
            for (int s = 0; s < 4; ++s) {
                u32x4 pw;
                if (s == 0) pw = (u32x4){pk2(p0[0], p0[1]), pk2(p0[2], p0[3]), pk2(p0[4], p0[5]), pk2(p0[6], p0[7])};
                else if (s == 1) pw = (u32x4){pk2(p0[8], p0[9]), pk2(p0[10], p0[11]), pk2(p0[12], p0[13]), pk2(p0[14], p0[15])};
                else if (s == 2) pw = (u32x4){pk2(p1[0], p1[1]), pk2(p1[2], p1[3]), pk2(p1[4], p1[5]), pk2(p1[6], p1[7])};
                else pw = (u32x4){pk2(p1[8], p1[9]), pk2(p1[10], p1[11]), pk2(p1[12], p1[13]), pk2(p1[14], p1[15])};
                const bf16x8 pf = __builtin_bit_cast(bf16x8, pw);
                const int kb = j0 + 16 * s + 4 * hi;
                {   const LAS unsigned char* vp = lds + AT_V_OFF + l31 * AT_VROW + kb * 2;
                    const u32x2 lo = *(const LAS u32x2*)vp, hh = *(const LAS u32x2*)(vp + 16);
                    o0 = mfma32(__builtin_bit_cast(bf16x8, (u32x4){lo.x, lo.y, hh.x, hh.y}), pf, o0); }
                {   const LAS unsigned char* vp = lds + AT_V_OFF + (32 + l31) * AT_VROW + kb * 2;
                    const u32x2 lo = *(const LAS u32x2*)vp, hh = *(const LAS u32x2*)(vp + 16);
                    o1 = mfma32(__builtin_bit_cast(bf16x8, (u32x4){lo.x, lo.y, hh.x, hh.y}), pf, o1); }
            }
        }
        const float ltot = lsum + SHX(lsum, 32, lane) + __builtin_amdgcn_exp2f(sinkL - mrun);
        const float inv = 1.0f / ltot;
        bf16_t* op = YA + tq * 512 + hq * 64 + 4 * hi;
#pragma unroll
        for (int rq = 0; rq < 4; ++rq) {
            u32x2 w0; w0.x = pk2(o0[4 * rq] * inv, o0[4 * rq + 1] * inv); w0.y = pk2(o0[4 * rq + 2] * inv, o0[4 * rq + 3] * inv); *(u32x2*)(op + 8 * rq) = w0;
            u32x2 w1; w1.x = pk2(o1[4 * rq] * inv, o1[4 * rq + 1] * inv); w1.y = pk2(o1[4 * rq + 2] * inv, o1[4 * rq + 3] * inv); *(u32x2*)(op + 32 + 8 * rq) = w1;
        }
    }
    __syncthreads();
}
constexpr int ML_ROW = 272;
constexpr int ML_Q = 0, ML_K = 128 * ML_ROW, ML_V = 2 * 128 * ML_ROW, ML_C = ML_V + 64 * ML_ROW, ML_SM = ML_C + 64 * ML_ROW;
constexpr int ML_SET = 2112;
constexpr int ML_N = ML_SM + 16 * ML_SET, ML_CW = ML_N + 512, ML_END = ML_CW + 4096;
static_assert(ML_END <= LDS_BYTES - 64, "mLSTM LDS");
__device__ __forceinline__ float logsig(float x) { const float ax = fabsf(x); return fminf(x, 0.f) - __logf(1.0f + __expf(-ax)); }
__device__ __forceinline__ void mlstm_chain(const Ctx& C, int chain, const float* cw, const float* cb) {
    const bf16_t* P1 = (const bf16_t*)(C.ws + WS_P1); const float* gates = (const float*)(C.ws + WS_GATE);
    const int b = chain >> 4, h = (chain >> 2) & 3, dir = (chain >> 1) & 1, half = chain & 1;
    bf16_t* HO = (bf16_t*)(C.ws + (dir ? WS_HB : WS_HF));
    LAS unsigned char* lds = C.lds; const int tid = C.tid, lane = C.lane, wave = C.wave, hi = lane >> 5, l31 = lane & 31;
    const size_t tokb = (size_t)b * SEQ;
    LAS float* nF = (LAS float*)(lds + ML_N); LAS float* cwS = (LAS float*)(lds + ML_CW);
    f32x16 cacc0;
#pragma unroll
    for (int r = 0; r < 16; ++r) cacc0[r] = 0.f;
    for (int i = tid; i < 64 * ML_ROW / 4; i += 512) ((LAS unsigned*)(lds + ML_C))[i] = 0u;
    if (tid < 128) nF[tid] = 0.f;
    for (int i = tid; i < 1024; i += 512) { const int qk = i >> 9, j = (i >> 7) & 3, d = i & 127; const int ch = qk * 512 + h * 128 + d; cwS[i] = (j < 3) ? cw[j * 1024 + ch] : cb[ch]; }
    float m_state = 0.f;
    const int gi = (dir ? 2 : 0) * 4 + h, gf = (dir ? 3 : 1) * 4 + h;
    const int dvh = wave >> 2, tb = dvh ? 3 - (wave & 3) : (wave & 3);
    const int dkb = wave & 3, dvq = wave >> 2;
    const int p = tid & 15, jb = (tid >> 4) * 4, chq = h * 128 + p * 8, pv = p & 7, kv0 = (p >> 3) * 2;
    u32x4 rq[6], rk[6], rv[2]; float gl0 = 0.f, gl1 = 0.f, gf0 = 0.f, gf1 = 0.f;
    const u32x4 z4 = (u32x4){0u, 0u, 0u, 0u};
#define ML_LOAD_RAW(STEP) do { const int cc_ = dir ? 15 - (STEP) : (STEP); const int pb_ = cc_ * 128; const int pl_ = dir ? pb_ + 124 - jb : pb_ + jb; \
        _Pragma("unroll") for (int k = 0; k < 6; ++k) { const int pos = pl_ - 1 + k; const bool ok = (pos >= 0) && (pos < SEQ); const bf16_t* r0 = P1 + (tokb + pos) * P1W; \
            rq[k] = ok ? *(const u32x4*)(r0 + 768 + chq) : z4; rk[k] = ok ? *(const u32x4*)(r0 + 1280 + chq) : z4; } \
        _Pragma("unroll") for (int k = 0; k < 2; ++k) rv[k] = *(const u32x4*)(P1 + (tokb + pl_ + kv0 + k) * P1W + 1792 + h * 128 + half * 64 + pv * 8); } while (0)
#define ML_LOAD_GATES(STEP) do { const int cc_ = dir ? 15 - (STEP) : (STEP); const int pb_ = cc_ * 128; const int pa = dir ? pb_ + 127 - lane : pb_ + lane, pc = dir ? pb_ + 63 - lane : pb_ + 64 + lane; \
        const float* ga = gates + (tokb + pa) * 16; const float* gb = gates + (tokb + pc) * 16; gl0 = ga[gi]; gf0 = ga[gf]; gl1 = gb[gi]; gf1 = gb[gf]; } while (0)
#define ML_SCAN(SETP) do { LAS float* uS_ = (LAS float*)(SETP); LAS float* pmS_ = uS_ + 128; LAS float* btS_ = uS_ + 256; LAS float* wS_ = uS_ + 384; LAS float* sc_ = uS_ + 512; \
        const int j0 = lane, j1 = lane + 64; float v0 = logsig(gf0), v1 = logsig(gf1); \
        _Pragma("unroll") for (int o = 1; o < 64; o <<= 1) { const float t0 = __int_as_float(__builtin_amdgcn_ds_bpermute(((lane >= o ? lane - o : lane) << 2), __float_as_int(v0))), t1 = __int_as_float(__builtin_amdgcn_ds_bpermute(((lane >= o ? lane - o : lane) << 2), __float_as_int(v1))); if (lane >= o) { v0 += t0; v1 += t1; } } \
        v1 += __int_as_float(__builtin_amdgcn_readlane(__float_as_int(v0), 63)); \
        const float u0 = gl0 - v0, u1 = gl1 - v1; float m0 = u0, m1 = u1; \
        _Pragma("unroll") for (int o = 1; o < 64; o <<= 1) { const float t0 = __int_as_float(__builtin_amdgcn_ds_bpermute(((lane >= o ? lane - o : lane) << 2), __float_as_int(m0))), t1 = __int_as_float(__builtin_amdgcn_ds_bpermute(((lane >= o ? lane - o : lane) << 2), __float_as_int(m1))); if (lane >= o) { m0 = fmaxf(m0, t0); m1 = fmaxf(m1, t1); } } \
        m1 = fmaxf(m1, __int_as_float(__builtin_amdgcn_readlane(__float_as_int(m0), 63))); \
        btS_[j0] = v0; btS_[j1] = v1; uS_[j0] = u0; uS_[j1] = u1; pmS_[j0] = m0; pmS_[j1] = m1; \
        if (lane == 63) { sc_[0] = v1; sc_[1] = m1; } \
        const float pml_ = __int_as_float(__builtin_amdgcn_readlane(__float_as_int(m1), 63)); \
        wS_[j0] = __expf(u0 - pml_); wS_[j1] = __expf(u1 - pml_); } while (0)
    ML_LOAD_RAW(0);
    for (int q = 0; q < 2; ++q) { const int st_ = 2 * wave + q; ML_LOAD_GATES(st_); ML_SCAN(lds + ML_SM + st_ * ML_SET); }
    __syncthreads();
    for (int step = 0; step < 16; ++step) {
        const int cc = dir ? 15 - step : step; const int pbase = cc * 128;
        LAS float* uS = (LAS float*)(lds + ML_SM + step * ML_SET); LAS float* pmS = uS + 128; LAS float* btS = uS + 256; LAS float* wS = uS + 384; LAS float* scal = uS + 512;
        {
#pragma unroll
            for (int qk = 0; qk < 2; ++qk) {
                float w0[8], w1[8], w2[8], bb[8]; const LAS float* cwp = cwS + qk * 512 + p * 8;
#pragma unroll
                for (int hf = 0; hf < 2; ++hf) {
                    const f32x4 a0 = *(const LAS f32x4*)(cwp + 4 * hf), a1 = *(const LAS f32x4*)(cwp + 128 + 4 * hf), a2 = *(const LAS f32x4*)(cwp + 256 + 4 * hf), a3 = *(const LAS f32x4*)(cwp + 384 + 4 * hf);
#pragma unroll
                    for (int i = 0; i < 4; ++i) { w0[4 * hf + i] = a0[i]; w1[4 * hf + i] = a1[i]; w2[4 * hf + i] = a2[i]; bb[4 * hf + i] = a3[i]; }
                }
                const float osc = qk ? 0.08838834764831845f : 1.0f; LAS unsigned char* dst = lds + (qk ? ML_K : ML_Q) + p * 16;
                float um[8], u0[8], up[8]; unpack8(qk ? rk[0] : rq[0], um); unpack8(qk ? rk[1] : rq[1], u0);
#pragma unroll
                for (int k = 0; k < 4; ++k) {
                    unpack8(qk ? rk[k + 2] : rq[k + 2], up);
                    float y[8];
#pragma unroll
                    for (int i = 0; i < 8; ++i) { const float a = um[i] * w0[i] + u0[i] * w1[i] + up[i] * w2[i] + bb[i]; y[i] = a * sigm(a) * osc; um[i] = u0[i]; u0[i] = up[i]; }
                    const int j = dir ? jb + 3 - k : jb + k;
                    *(LAS u32x4*)(dst + j * ML_ROW) = pack8(y);
                }
                __builtin_amdgcn_sched_barrier(0);
            }
#pragma unroll
            for (int k = 0; k < 2; ++k) { const int kk = kv0 + k; const int j = dir ? jb + 3 - kk : jb + kk; const unsigned vw[4] = {rv[k].x, rv[k].y, rv[k].z, rv[k].w};
#pragma unroll
                for (int i = 0; i < 8; ++i) { const bf16_t e2 = (bf16_t)((i & 1) ? (vw[i >> 1] >> 16) : (vw[i >> 1] & 0xffffu)); *(LAS bf16_t*)(lds + ML_V + (pv * 8 + i) * ML_ROW + j * 2) = e2; } }
        }
        __syncthreads();
        if (step < 15) { ML_LOAD_RAW(step + 1); }
        const float btot = scal[0], pml = scal[1];
        const float m_in = m_state, a_max = btot + pml, m_new = fmaxf(btot + m_in, a_max);
        const float s_p = __expf(btot + m_in - m_new), s_l = __expf(a_max - m_new);
        {
            const int t = 32 * tb + l31;
            bf16x8 qf[8];
#pragma unroll
            for (int ks = 0; ks < 8; ++ks) qf[ks] = *(const LAS bf16x8*)(lds + ML_Q + t * ML_ROW + (16 * ks + 8 * hi) * 2);
            const float Mt = fmaxf(m_in, pmS[t]), bt = btS[t];
            const float scale_in = __expf(m_in - Mt);
            float qn = 0.f;
#pragma unroll
            for (int ks = 0; ks < 8; ++ks) { float qv[8]; unpack8(__builtin_bit_cast(u32x4, qf[ks]), qv); const LAS f32x4* np = (const LAS f32x4*)(nF + 16 * ks + 8 * hi); const f32x4 n0 = np[0], n1 = np[1];
                qn += qv[0] * n0.x + qv[1] * n0.y + qv[2] * n0.z + qv[3] * n0.w + qv[4] * n1.x + qv[5] * n1.y + qv[6] * n1.z + qv[7] * n1.w; }
            qn += SHX(qn, 32, lane);
            f32x16 oa0;
#pragma unroll
            for (int r = 0; r < 16; ++r) oa0[r] = 0.f;
            const int dv0 = 32 * dvh + l31;
#pragma unroll
            for (int ks = 0; ks < 8; ++ks) { const bf16x8 c0 = *(const LAS bf16x8*)(lds + ML_C + dv0 * ML_ROW + (16 * ks + 8 * hi) * 2); oa0 = mfma32(c0, qf[ks], oa0); }
#pragma unroll
            for (int r = 0; r < 16; ++r) oa0[r] *= scale_in;
            float dsum = 0.f;
            for (int sb = 0; sb <= tb; ++sb) {
                f32x16 st;
#pragma unroll
                for (int r = 0; r < 16; ++r) st[r] = 0.f;
#pragma unroll
                for (int ks = 0; ks < 8; ++ks) { const bf16x8 kf = *(const LAS bf16x8*)(lds + ML_K + (32 * sb + l31) * ML_ROW + (16 * ks + 8 * hi) * 2); st = mfma32(kf, qf[ks], st); }
#pragma unroll
                for (int r = 0; r < 16; ++r) { const int s = 32 * sb + crow(r, hi); const float pw = __expf(uS[s] - Mt); const float v = (s <= t) ? st[r] * pw : 0.f; st[r] = v; dsum += v; }
#pragma unroll
                for (int s2 = 0; s2 < 2; ++s2) {
                    const u32x4 pw = (s2 == 0) ? (u32x4){pk2(st[0], st[1]), pk2(st[2], st[3]), pk2(st[4], st[5]), pk2(st[6], st[7])} : (u32x4){pk2(st[8], st[9]), pk2(st[10], st[11]), pk2(st[12], st[13]), pk2(st[14], st[15])};
                    const bf16x8 pf = __builtin_bit_cast(bf16x8, pw);
                    const int kb = 32 * sb + 16 * s2 + 4 * hi;
                    const LAS unsigned char* vp = lds + ML_V + dv0 * ML_ROW + kb * 2; const u32x2 lo = *(const LAS u32x2*)vp, hh = *(const LAS u32x2*)(vp + 16);
                    oa0 = mfma32(__builtin_bit_cast(bf16x8, (u32x4){lo.x, lo.y, hh.x, hh.y}), pf, oa0);
                }
            }
            const float den = dsum + SHX(dsum, 32, lane) + scale_in * qn;
            const float dd = fmaxf(fabsf(den), __expf(-(bt + Mt))); const float inv = 1.0f / dd;
            const int pos = dir ? pbase + 127 - t : pbase + t;
            bf16_t* op = HO + (tokb + pos) * 512 + h * 128 + half * 64 + 32 * dvh + 4 * hi;
#pragma unroll
            for (int rq2 = 0; rq2 < 4; ++rq2) { u32x2 w0; w0.x = pk2(oa0[4 * rq2] * inv, oa0[4 * rq2 + 1] * inv); w0.y = pk2(oa0[4 * rq2 + 2] * inv, oa0[4 * rq2 + 3] * inv); *(u32x2*)(op + 8 * rq2) = w0; }
        }
        __syncthreads();
        {
#pragma unroll
            for (int r = 0; r < 16; ++r) cacc0[r] *= s_p;
            float nsum = 0.f;
            const int dk = 32 * dkb + l31, dv0 = 32 * dvq + l31;
#pragma unroll
            for (int ks = 0; ks < 8; ++ks) {
                float kw[8]; const LAS f32x4* wp = (const LAS f32x4*)(wS + 16 * ks + 8 * hi); const f32x4 wa = wp[0], wb = wp[1]; const float ww[8] = {wa.x * s_l, wa.y * s_l, wa.z * s_l, wa.w * s_l, wb.x * s_l, wb.y * s_l, wb.z * s_l, wb.w * s_l};
                bf16_t kr[8];
#pragma unroll
                for (int i = 0; i < 8; ++i) { const int s = 16 * ks + 8 * hi + i; kr[i] = *(const LAS bf16_t*)(lds + ML_K + s * ML_ROW + dk * 2); }
                __builtin_amdgcn_sched_barrier(0);
#pragma unroll
                for (int i = 0; i < 8; ++i) { kw[i] = bf2f(kr[i]) * ww[i]; nsum += kw[i]; }
                const bf16x8 bfr = __builtin_bit_cast(bf16x8, pack8(kw));
                const bf16x8 a0 = *(const LAS bf16x8*)(lds + ML_V + dv0 * ML_ROW + (16 * ks + 8 * hi) * 2);
                cacc0 = mfma32(a0, bfr, cacc0);
            }
            nsum += SHX(nsum, 32, lane);
            if (dvq == 0 && hi == 0) nF[dk] = s_p * nF[dk] + nsum;
#pragma unroll
            for (int r = 0; r < 16; ++r) *(LAS bf16_t*)(lds + ML_C + (32 * dvq + crow(r, hi)) * ML_ROW + dk * 2) = f2bf(cacc0[r]);
            m_state = m_new;
        }
        __syncthreads();
    }
#undef ML_LOAD_RAW
#undef ML_LOAD_GATES
#undef ML_SCAN
}
#define XB_TMO      128
#define XB_XCNT(j)  (256  + 64 * (j))
#define XB_XSUB(j)  (1280 + 64 * (j))
#define XB_XGEN(j)  (2304 + 64 * (j))
#define XB_TOP      3328
#define XB_TOPGEN   3392
#define XCD_BAR_WORDS 3456
#define XB_SPIN_CAP (1u << 18)

__device__ __forceinline__ unsigned xb_ld(unsigned* p)              { return __hip_atomic_load(p, __ATOMIC_RELAXED, __HIP_MEMORY_SCOPE_AGENT); }
__device__ __forceinline__ unsigned xb_add(unsigned* p, unsigned v) { return __hip_atomic_fetch_add(p, v, __ATOMIC_RELAXED, __HIP_MEMORY_SCOPE_AGENT); }
__device__ __forceinline__ unsigned xb_xcc_id() { return (unsigned)__builtin_amdgcn_s_getreg((3 << 11) | 20) & 0xFu; }
#define XB_SPIN(cond, bar) do { unsigned _sp = 0; while (cond) { __builtin_amdgcn_s_sleep(1); \
    if ((++_sp & 255u) == 0u) { if (xb_ld(&(bar)[XB_TMO])) break; if (_sp > XB_SPIN_CAP) { atomicAdd(&(bar)[XB_TMO], 1u); break; } } } } while (0)

struct XcdBarrier {
    unsigned* bar; unsigned x;
    volatile LAS unsigned* st;
};

__device__ __forceinline__ XcdBarrier xcd_barrier_post(unsigned* bar, volatile LAS unsigned* st) {
    XcdBarrier b; b.bar = bar; b.x = xb_xcc_id(); b.st = st;
    if (threadIdx.x == 0) (void)xb_add(&bar[XB_XCNT(b.x)], 1u);
    return b;
}
__device__ __forceinline__ void xcd_barrier_complete(unsigned* bar, unsigned x, unsigned& nloc, unsigned& nx) {
    const unsigned G = gridDim.x * gridDim.y * gridDim.z;
    unsigned sum, cnt, mine, sp = 0u;
    for (;;) {
        sum = 0u; cnt = 0u; mine = 0u;
#pragma unroll
        for (unsigned j = 0; j < 16; ++j) { const unsigned c = xb_ld(&bar[XB_XCNT(j)]); sum += c; cnt += (c > 0u) ? 1u : 0u; mine = (j == x) ? c : mine; }
        if (sum == G) break;
        __builtin_amdgcn_s_sleep(1);
        if ((++sp & 255u) == 0u) { if (xb_ld(&bar[XB_TMO])) break; if (sp > XB_SPIN_CAP) { atomicAdd(&bar[XB_TMO], 1u); break; } }
    }
    nloc = mine > 0u ? mine : 1u; nx = cnt > 0u ? cnt : 1u;
}

__device__ __forceinline__ void xcd_barrier(const XcdBarrier& b) {
    asm volatile("s_waitcnt vmcnt(0)" ::: "memory");
    __syncthreads();
    if (threadIdx.x == 0) {
        unsigned* bar = b.bar;
        __builtin_amdgcn_s_waitcnt(0);
        unsigned nloc = b.st[0], nx = b.st[1];
        if (nloc == 0u) { xcd_barrier_complete(bar, b.x, nloc, nx); b.st[0] = nloc; b.st[1] = nx; }
        const unsigned old = xb_add(&bar[XB_XSUB(b.x)], 1u);
        const unsigned gen = old / nloc;
        if (old + 1u == (gen + 1u) * nloc) {
            __builtin_amdgcn_fence(__ATOMIC_RELEASE, "agent");
            asm volatile("s_waitcnt vmcnt(0)" ::: "memory");
            const unsigned og = xb_add(&bar[XB_TOP], 1u);
            const unsigned tg = og / nx;
            if (og + 1u == (tg + 1u) * nx) xb_add(&bar[XB_TOPGEN], 1u);
            else XB_SPIN(xb_ld(&bar[XB_TOPGEN]) == tg, bar);
            __builtin_amdgcn_fence(__ATOMIC_ACQUIRE, "agent");
            xb_add(&bar[XB_XGEN(b.x)], 1u);
            asm volatile("s_waitcnt vmcnt(0)" ::: "memory");
        } else {
            XB_SPIN(xb_ld(&bar[XB_XGEN(b.x)]) == gen, bar);
            __builtin_amdgcn_fence(__ATOMIC_ACQUIRE, "agent");
            asm volatile("s_waitcnt vmcnt(0)" ::: "memory");
        }
    }
    __syncthreads();
}


constexpr int XB_LDS_OFF = LDS_BYTES - 64;
constexpr size_t WS_BAR = 0;
struct Args { const float* in[23]; float* out; unsigned char* ws; int ph_lo, ph_hi; };
template <class Epi> __device__ __forceinline__ void run_gemm(const Ctx& C, const bf16_t* A, const bf16_t* Bt, int N, int K, const Epi& E) {
    pg8::Gemm g{A, Bt, M, N, K}; pg8::StaticOrder S; S.init(M, N, C.G, C.bid);
    pg8::gemm_phase<Epi, pg8::StaticOrder, true, true>(C.lds, g, S, E);
}
__global__ void __launch_bounds__(512, 2) fwd_kernel(Args a) {
    extern __shared__ __attribute__((aligned(16))) unsigned char lds_raw[];
    cg::grid_group grid = cg::this_grid();
    Ctx C;
    C.X = a.out; C.ws = a.ws; C.lds = (LAS unsigned char*)lds_raw;
    C.G = gridDim.x; C.bid = blockIdx.x;
    unsigned char* ws = a.ws;
    bf16_t* XN = (bf16_t*)(ws + WS_XN); bf16_t* P1 = (bf16_t*)(ws + WS_P1); bf16_t* OM = (bf16_t*)(ws + WS_OM); bf16_t* YA = (bf16_t*)(ws + WS_YA); bf16_t* YM = (bf16_t*)(ws + WS_HF);
    bf16_t* HH = (bf16_t*)(ws + WS_P1); bf16_t* ZA = (bf16_t*)(ws + WS_P1); bf16_t* ZM = (bf16_t*)(ws + WS_P1 + 64 * MiB);
    if (threadIdx.x < 16) ((LAS unsigned*)(C.lds + XB_LDS_OFF))[threadIdx.x] = 0u;
    __syncthreads();
    XcdBarrier bar = xcd_barrier_post((unsigned*)(ws + WS_BAR), (volatile LAS unsigned*)(C.lds + XB_LDS_OFF));
    for (int ph = a.ph_lo; ph < a.ph_hi; ++ph) {
        { int t_ = threadIdx.x; asm volatile("" : "+v"(t_)); C.tid = t_; C.lane = t_ & 63; C.wave = __builtin_amdgcn_readfirstlane(t_ >> 6); }
        if (ph == 0) {
            prologue_weights(C, a.in[3], a.in[4], a.in[5], a.in[7], a.in[15], a.in[16], a.in[17], a.in[19], a.in[20], a.in[21]); prologue_rope(C, (const int*)a.in[1]);
            norm_pass<0>(C, a.in[0], a.in[2], nullptr, nullptr, nullptr);
        } else {
            const int l = (ph - 1) / NSUB, sp = (ph - 1) % NSUB;
            const unsigned char* wl = ws + WS_W + (size_t)l * W_LAYER;
            switch (sp) {
            case 0: case 9: {
                pg8::EpiSwiGLU E{HH, FF}; run_gemm(C, XN, (const bf16_t*)(wl + (sp == 0 ? WO_GU1 : WO_GU2)), NGU, DM, E); break; }
            case 1: case 10: {
                pg8::EpiResid E{(l == 0 && sp == 1) ? a.in[0] : C.X, C.X, 0.5f};
                run_gemm(C, HH, (const bf16_t*)(wl + (sp == 1 ? WO_D1 : WO_D2)), DM, FF, E);
                break; }
            case 2: norm_pass<1>(C, C.X, a.in[6] + l * DM, nullptr, a.in[7] + (size_t)l * DM * INW, a.in[8] + l * 16); break;
            case 3: { pg8::EpiStore E{P1, P1W, 9, OM, 512}; run_gemm(C, XN, (const bf16_t*)(wl + WO_IN), NINA, DM, E); break; }
            case 4: {
                for (int c = C.bid; c < 256; c += C.G) mlstm_chain(C, c, a.in[12] + (size_t)l * 3 * 1024, a.in[13] + (size_t)l * 1024);
                for (int u = C.bid; u < 512; u += C.G) attn_unit(C, u, a.in[9] + l * 64, a.in[10] + l * 64, a.in[11] + l * 8);
                break; }
            case 5: {
                mc_pass(C, a.in[14] + l * 512);
                { pg8::EpiStore E{ZA, DM, 1 << 20, nullptr, 0}; run_gemm(C, YA, (const bf16_t*)(wl + WO_A), DM, 512, E); }
                { pg8::EpiGate<0> E{ZA, nullptr}; run_gemm(C, XN, (const bf16_t*)(wl + WO_IN) + (size_t)NINA * DM, DM, DM, E); }
                break; }
            case 6: {
                { pg8::EpiStore E{ZM, DM, 1 << 20, nullptr, 0}; run_gemm(C, YM, (const bf16_t*)(wl + WO_B), DM, 512, E); }
                { pg8::EpiGate<1> E{ZA, ZM}; run_gemm(C, XN, (const bf16_t*)(wl + WO_IN) + (size_t)(NINA + 1024) * DM, DM, DM, E); }
                break; }
            case 7: {
                pg8::EpiResid E{C.X, C.X, 1.0f};
                run_gemm(C, ZA, (const bf16_t*)(wl + WO_O), DM, DM, E);
                break; }
            case 8: norm_pass<2>(C, C.X, a.in[18] + l * DM, nullptr, nullptr, nullptr); break;
            case 11: norm_pass<3>(C, C.X, a.in[22] + l * DM, (l + 1 < DEPTH) ? a.in[2] + (l + 1) * DM : nullptr, nullptr, nullptr); break;
            default: break;
            }
        }
        if (ph + 1 < a.ph_hi) { if (a.ph_hi < 0) grid.sync(); else xcd_barrier(bar); }
    }
}
}

#ifndef MK_MULTI
#define MK_MULTI 0
#endif
extern "C" void kernel_launch(void* const* d_in, const int* in_sizes, int n_in, void* d_out, int out_size, void* d_ws, size_t ws_size, hipStream_t stream) {
    using namespace mk;
    static int grid = 0;
    if (grid == 0) {
        if (n_in != 23 || out_size != M * DM || ws_size < WS_END) { fprintf(stderr, "kernel_launch: unexpected sizes (n_in %d out %d ws %zu)\n", n_in, out_size, ws_size); grid = -1; return; }
        int dev = 0, cus = 0, per_cu = 0;
        (void)hipGetDevice(&dev); (void)hipDeviceGetAttribute(&cus, hipDeviceAttributeMultiprocessorCount, dev);
        (void)hipFuncSetAttribute((const void*)fwd_kernel, hipFuncAttributeMaxDynamicSharedMemorySize, LDS_BYTES);
        if (hipOccupancyMaxActiveBlocksPerMultiprocessor(&per_cu, (const void*)fwd_kernel, 512, LDS_BYTES) != hipSuccess || per_cu < 1) per_cu = 1;
        (void)hipGetLastError();
        if (per_cu > 1) per_cu = 1;
        grid = cus * per_cu; if (grid <= 0) grid = 256;
    }
    if (grid < 0) return;
    (void)hipMemsetAsync((char*)d_ws + WS_BAR, 0, XCD_BAR_WORDS * 4, stream);
    Args a{};
    for (int i = 0; i < 23; ++i) a.in[i] = (const float*)d_in[i];
    a.out = (float*)d_out; a.ws = (unsigned char*)d_ws;
#if MK_MULTI
    for (int ph = 0; ph < NPHASE; ++ph) { a.ph_lo = ph; a.ph_hi = ph + 1; hipLaunchKernelGGL(fwd_kernel, dim3(grid), dim3(512), LDS_BYTES, stream, a); }
#else
    a.ph_lo = 0; a.ph_hi = NPHASE;
    void* args[] = {&a};
    hipError_t e = hipLaunchCooperativeKernel((const void*)fwd_kernel, dim3(grid), dim3(512), args, LDS_BYTES, stream);
    if (e != hipSuccess) fprintf(stderr, "cooperative launch failed: %s (grid %d)\n", hipGetErrorString(e), grid);
#endif
}
```

```cpp
#include <hip/hip_runtime.h>
#include <hip/hip_cooperative_groups.h>
#include <cstdio>
#include <cstdint>
namespace cg = cooperative_groups;
#define SHX(v, m, ln) __int_as_float(__builtin_amdgcn_ds_bpermute((((ln) ^ (m)) << 2), __float_as_int(v)))
namespace pg8 {
#define PG8_LAS __attribute__((address_space(3)))
typedef unsigned short bf16_t;
typedef short bf16x8 __attribute__((ext_vector_type(8)));
typedef float f32x4 __attribute__((ext_vector_type(4)));
typedef unsigned u32x4 __attribute__((ext_vector_type(4)));
constexpr int BM = 256, BK = 64, HALF = 128, HTB = HALF * BK * 2  , STAGE_BYTES = 8 * HTB, NXCD = 8, WGM = 4;

__host__ __device__ __forceinline__ int lds_byte(int r, int c) { const int st = (r >> 4) * 2 + (c >> 5), rr = r & 15, cc = c & 31, ob = rr * 64 + cc * 2; return st * 1024 + (ob ^ (((ob >> 9) & 1) << 5)); }
__host__ __device__ __forceinline__ void stage_rc(int b, int& R, int& C) { const int st = b / 1024, sb = b % 1024, swz = sb ^ (((sb >> 9) & 1) << 5); R = (st >> 1) * 16 + swz / 64; C = (st & 1) * 32 + (swz % 64) / 2; }
__host__ __device__ __forceinline__ int perm32(int rho) { const int n = rho >> 4, i = rho & 15; return 8 * (i >> 2) + 4 * n + (i & 3); }

struct Unit { int pm, pn; };
struct Gemm { const bf16_t* A; const bf16_t* Bt; int M, N, K; };

struct StaticOrder {
    int nM, nN, nwg, G, c;
    __host__ __device__ void init(int M, int N, int G_, int c_) { nM = M / BM; nN = N / BM; nwg = nM * nN; G = G_; c = c_; }
    __host__ __device__ bool next(int i, Unit& u) const {
        const long L = (long)i * G + c; if (L >= nwg) return false;
        int wgid = (int)L; { const int q = nwg / NXCD, r = nwg % NXCD, xcd = wgid % NXCD, off = wgid / NXCD; wgid = (xcd < r ? xcd * (q + 1) : r * (q + 1) + (xcd - r) * q) + off; }
        const int nig = WGM * nN, gid = wgid / nig, fm = gid * WGM, gsz = (nM - fm) < WGM ? (nM - fm) : WGM;
        u.pm = fm + ((wgid % nig) % gsz); u.pn = (wgid % nig) / gsz; return true;
    }
    __device__ __forceinline__ void a_ready(const Unit&) const {}
    __device__ __forceinline__ void done(const Unit&) const {}
};

__device__ __forceinline__ unsigned cvt_pk_bf16(float lo, float hi) { unsigned r; asm volatile("v_cvt_pk_bf16_f32 %0, %1, %2" : "=v"(r) : "v"(lo), "v"(hi)); return r; }
typedef unsigned u32x2 __attribute__((ext_vector_type(2)));
__device__ __forceinline__ float sigm(float x) { return __builtin_amdgcn_rcpf(1.0f + __builtin_amdgcn_exp2f(-1.4426950408889634f * x)); }
__device__ __forceinline__ float bflo(unsigned w) { return __uint_as_float(w << 16); }
__device__ __forceinline__ float bfhi(unsigned w) { return __uint_as_float(w & 0xffff0000u); }
struct EpiSwiGLU { static constexpr bool PERM = true, AFTER_DRAIN = false;
    bf16_t* O; int ldo;
    __device__ __forceinline__ void operator()(const f32x4 (&acc)[2][2][4][2], const Unit& u, int wr, int wc, int fr, int fq) const {
        const int row0 = u.pm * BM + wr * 64 + fr, hc0 = u.pn * 128 + wc * 32 + 8 * fq;
#pragma unroll
        for (int ai = 0; ai < 2; ++ai)
#pragma unroll
            for (int m = 0; m < 4; ++m) { bf16_t* rowp = O + (size_t)(row0 + ai * HALF + m * 16) * ldo + hc0; float h[8];
#pragma unroll
                for (int n = 0; n < 2; ++n) { const f32x4 g = acc[ai][0][m][n], up = acc[ai][1][m][n];
#pragma unroll
                    for (int i = 0; i < 4; ++i) h[4 * n + i] = g[i] * sigm(g[i]) * up[i]; }
                u32x4 w; w.x = cvt_pk_bf16(h[0], h[1]); w.y = cvt_pk_bf16(h[2], h[3]); w.z = cvt_pk_bf16(h[4], h[5]); w.w = cvt_pk_bf16(h[6], h[7]); *(u32x4*)rowp = w; }
    }
};
struct EpiResid { static constexpr bool PERM = true, AFTER_DRAIN = false;
    const float* Xs; float* X; float s;
    __device__ __forceinline__ void operator()(const f32x4 (&acc)[2][2][4][2], const Unit& u, int wr, int wc, int fr, int fq) const {
        const int row0 = u.pm * BM + wr * 64 + fr, col0 = u.pn * BM + wc * 32 + 8 * fq;
#pragma unroll
        for (int ai = 0; ai < 2; ++ai)
#pragma unroll
        for (int mb = 0; mb < 4; mb += 2) { f32x4 xa[2][2][2];
#pragma unroll
            for (int mi = 0; mi < 2; ++mi) { const float* rows = Xs + (size_t)(row0 + ai * HALF + (mb + mi) * 16) * 1024 + col0;
#pragma unroll
                for (int bj = 0; bj < 2; ++bj) { const f32x4* ps = (const f32x4*)(rows + bj * HALF); xa[mi][bj][0] = ps[0]; xa[mi][bj][1] = ps[1]; } }
#pragma unroll
            for (int mi = 0; mi < 2; ++mi) { const int m = mb + mi; float* rowp = X + (size_t)(row0 + ai * HALF + m * 16) * 1024 + col0;
#pragma unroll
                for (int bj = 0; bj < 2; ++bj) { f32x4* p = (f32x4*)(rowp + bj * HALF); p[0] = xa[mi][bj][0] + acc[ai][bj][m][0] * s; p[1] = xa[mi][bj][1] + acc[ai][bj][m][1] * s; } }
            asm volatile("" ::: "memory"); }
    }
};
struct EpiStore { static constexpr bool PERM = true, AFTER_DRAIN = false;
    bf16_t* O0; int ld0, nt0; bf16_t* O1; int ld1;
    __device__ __forceinline__ void operator()(const f32x4 (&acc)[2][2][4][2], const Unit& u, int wr, int wc, int fr, int fq) const {
        const int row0 = u.pm * BM + wr * 64 + fr; bf16_t* base; int ld, colt;
        if (u.pn < nt0) { base = O0; ld = ld0; colt = u.pn * BM; } else { base = O1; ld = ld1; colt = (u.pn - nt0) * BM; }
        const int col0 = colt + wc * 32 + 8 * fq;
#pragma unroll
        for (int ai = 0; ai < 2; ++ai)
#pragma unroll
            for (int m = 0; m < 4; ++m) { bf16_t* rowp = base + (size_t)(row0 + ai * HALF + m * 16) * ld + col0;
#pragma unroll
                for (int bj = 0; bj < 2; ++bj) { const f32x4 v0 = acc[ai][bj][m][0], v1 = acc[ai][bj][m][1]; u32x4 w; w.x = cvt_pk_bf16(v0[0], v0[1]); w.y = cvt_pk_bf16(v0[2], v0[3]); w.z = cvt_pk_bf16(v1[0], v1[1]); w.w = cvt_pk_bf16(v1[2], v1[3]);
                    *(u32x4*)(rowp + bj * HALF) = w; } }
    }
};
template <int MODE> struct EpiGate { static constexpr bool PERM = true, AFTER_DRAIN = false;
    bf16_t* Z; const bf16_t* ZM;
    __device__ __forceinline__ void operator()(const f32x4 (&acc)[2][2][4][2], const Unit& u, int wr, int wc, int fr, int fq) const {
        const int row0 = u.pm * BM + wr * 64 + fr, col0 = u.pn * BM + wc * 32 + 8 * fq;
        constexpr int NB = (MODE == 0) ? 2 : 1;
#pragma unroll
        for (int ai = 0; ai < 2; ++ai)
#pragma unroll
        for (int mb = 0; mb < 4; mb += NB) { u32x4 zz[NB][2], yy[NB][2];
#pragma unroll
            for (int mi = 0; mi < NB; ++mi) { const size_t off = (size_t)(row0 + ai * HALF + (mb + mi) * 16) * 1024 + col0;
#pragma unroll
                for (int bj = 0; bj < 2; ++bj) { zz[mi][bj] = *(const u32x4*)(Z + off + bj * HALF); if (MODE == 1) yy[mi][bj] = *(const u32x4*)(ZM + off + bj * HALF); } }
#pragma unroll
            for (int mi = 0; mi < NB; ++mi) { const int m = mb + mi; const size_t off = (size_t)(row0 + ai * HALF + m * 16) * 1024 + col0;
#pragma unroll
                for (int bj = 0; bj < 2; ++bj) { const f32x4 v0 = acc[ai][bj][m][0], v1 = acc[ai][bj][m][1];
                    const u32x4 z = zz[mi][bj]; float zf[8] = {bflo(z.x), bfhi(z.x), bflo(z.y), bfhi(z.y), bflo(z.z), bfhi(z.z), bflo(z.w), bfhi(z.w)};
                    float o[8];
                    if (MODE == 0) {
#pragma unroll
                        for (int i = 0; i < 4; ++i) { o[i] = sigm(v0[i]) * zf[i]; o[4 + i] = sigm(v1[i]) * zf[4 + i]; }
                    } else { const u32x4 y = yy[mi][bj]; float yf[8] = {bflo(y.x), bfhi(y.x), bflo(y.y), bfhi(y.y), bflo(y.z), bfhi(y.z), bflo(y.w), bfhi(y.w)};
#pragma unroll
                        for (int i = 0; i < 4; ++i) { o[i] = zf[i] + sigm(v0[i]) * yf[i]; o[4 + i] = zf[4 + i] + sigm(v1[i]) * yf[4 + i]; }
                    }
                    u32x4 w; w.x = cvt_pk_bf16(o[0], o[1]); w.y = cvt_pk_bf16(o[2], o[3]); w.z = cvt_pk_bf16(o[4], o[5]); w.w = cvt_pk_bf16(o[6], o[7]);
                    *(u32x4*)(Z + off + bj * HALF) = w; } }
            asm volatile("" ::: "memory"); }
    }
};
template <class Epi, class Sched, bool ALIGN_EPI = false, bool SP2 = false>
__device__ __forceinline__ void gemm_phase(PG8_LAS unsigned char* lds, const Gemm g, const Sched& S, const Epi& E) {
    int tid_ = threadIdx.x; asm volatile("" : "+v"(tid_)); const int tid = tid_, wid = __builtin_amdgcn_readfirstlane(tid >> 6), lane = tid & 63, wr = wid >> 2, wc = wid & 3, fr = lane & 15, fq = lane >> 4;
    const int K = g.K, nt = K / BK;
    unsigned voffA[2], voffB[2];
#pragma unroll
    for (int i = 0; i < 2; ++i) { int R, C; stage_rc(tid * 16 + i * 8192, R, C); const int Rb = Epi::PERM ? ((R & ~31) + perm32(R & 31)) : R;
        voffA[i] = (unsigned)(R * K + C) * 2u; voffB[i] = (unsigned)(Rb * K + C) * 2u; }
    const size_t kstep = (size_t)(BK * 2);
    const size_t hstep = (size_t)HALF * K * 2;
    const size_t tstep = 2 * hstep;
    const unsigned ldsw = (unsigned)wid * 1024u;
    const int aoff = lds_byte(wr * 64 + fr, fq * 8), boff = lds_byte(wc * 32 + fr, fq * 8);
#define PG8_SA(b, h) (((b) * 2 + (h)) * HTB)
#define PG8_SB(b, h) ((4 + (b) * 2 + (h)) * HTB)
#define PG8_STAGE(bufoff, gbase, voff) do { _Pragma("unroll") for (int _i = 0; _i < 2; ++_i) \
        __builtin_amdgcn_global_load_lds((const unsigned*)((const char*)(gbase) + (voff)[_i]), (PG8_LAS unsigned*)(lds + (bufoff) + ldsw + _i * 8192), 16, 0, 0); } while (0)
#define PG8_LDA(dst, b, h) do { _Pragma("unroll") for (int m = 0; m < 4; ++m) _Pragma("unroll") for (int k = 0; k < 2; ++k) dst[m][k] = *(const PG8_LAS bf16x8*)(lds + PG8_SA(b, h) + aoff + m * 2048 + k * 1024); } while (0)
#define PG8_LDB(dst, b, h) do { _Pragma("unroll") for (int n = 0; n < 2; ++n) _Pragma("unroll") for (int k = 0; k < 2; ++k) dst[n][k] = *(const PG8_LAS bf16x8*)(lds + PG8_SB(b, h) + boff + n * 2048 + k * 1024); } while (0)
#define PG8_MMA(ai, bj, At, Bt) do { __builtin_amdgcn_s_setprio(1); _Pragma("unroll") for (int m = 0; m < 4; ++m) _Pragma("unroll") for (int n = 0; n < 2; ++n) _Pragma("unroll") for (int k = 0; k < 2; ++k) \
        acc[ai][bj][m][n] = __builtin_amdgcn_mfma_f32_16x16x32_bf16(Bt[n][k], At[m][k], acc[ai][bj][m][n], 0, 0, 0); __builtin_amdgcn_s_setprio(0); } while (0)
#define PG8_WAIT_V(n) asm volatile("s_waitcnt vmcnt(" #n ")" ::: "memory")
#define PG8_WAIT_L(n) asm volatile("s_waitcnt lgkmcnt(" #n ")" ::: "memory")
#define PG8_BAR __builtin_amdgcn_s_barrier()
#define PG8_SCHED __builtin_amdgcn_sched_barrier(0)
    Unit cur, nxt; int ui = 0;
    if (!S.next(0, cur)) return;
    f32x4 acc[2][2][4][2];
#pragma unroll
    for (int a = 0; a < 2; ++a)
#pragma unroll
        for (int b = 0; b < 2; ++b)
#pragma unroll
            for (int m = 0; m < 4; ++m)
#pragma unroll
                for (int n = 0; n < 2; ++n) acc[a][b][m][n] = (f32x4){0.f, 0.f, 0.f, 0.f};
    bf16x8 At[4][2], B0[2][2], B1[2][2];
    const char* cA = (const char*)g.A + (size_t)cur.pm * tstep; const char* cB = (const char*)g.Bt + (size_t)cur.pn * tstep;
    S.a_ready(cur);
    if constexpr (SP2) {
        PG8_STAGE(PG8_SB(0, 0), cB, voffB); PG8_STAGE(PG8_SB(0, 1), cB + hstep, voffB); PG8_STAGE(PG8_SA(0, 0), cA, voffA); PG8_STAGE(PG8_SA(0, 1), cA + hstep, voffA);
        if (wr == 1) PG8_BAR;
        PG8_WAIT_V(2); PG8_BAR;
        PG8_STAGE(PG8_SB(1, 0), cB + kstep, voffB); PG8_STAGE(PG8_SA(1, 0), cA + kstep, voffA); PG8_STAGE(PG8_SB(1, 1), cB + hstep + kstep, voffB);
        PG8_WAIT_V(6); PG8_BAR;
    } else {
        PG8_STAGE(PG8_SB(0, 0), cB, voffB); PG8_STAGE(PG8_SA(0, 0), cA, voffA); PG8_STAGE(PG8_SB(0, 1), cB + hstep, voffB); PG8_STAGE(PG8_SA(0, 1), cA + hstep, voffA);
        if (wr == 1) PG8_BAR;
        PG8_WAIT_V(4); PG8_BAR;
        PG8_STAGE(PG8_SB(1, 0), cB + kstep, voffB); PG8_STAGE(PG8_SA(1, 0), cA + kstep, voffA); PG8_STAGE(PG8_SB(1, 1), cB + hstep + kstep, voffB);
        PG8_WAIT_V(6); PG8_BAR;
    }
    for (;;) {
        const bool has_next = S.next(ui + 1, nxt);
        const char* nA = has_next ? (const char*)g.A + (size_t)nxt.pm * tstep : cA; const char* nB = has_next ? (const char*)g.Bt + (size_t)nxt.pn * tstep : cB;
        for (int t = 0; t < nt; t += 2) {
            const bool last = (t == nt - 2);
            const char* a1 = cA + (size_t)(t + 1) * kstep;
            const char* a2 = last ? nA : cA + (size_t)(t + 2) * kstep; const char* b2 = last ? nB : cB + (size_t)(t + 2) * kstep;
            const char* a3 = a2 + kstep; const char* b3 = b2 + kstep;
            if (last && has_next) S.a_ready(nxt);
            if constexpr (SP2) {
            PG8_LDB(B0, 0, 0); PG8_LDB(B1, 0, 1); PG8_SCHED; PG8_LDA(At, 0, 0); PG8_STAGE(PG8_SA(1, 1), a1 + hstep, voffA);
            PG8_WAIT_V(8); PG8_WAIT_L(0); PG8_BAR; PG8_MMA(0, 0, At, B0); PG8_MMA(0, 1, At, B1); PG8_BAR; PG8_SCHED;
            PG8_LDA(At, 0, 1); PG8_STAGE(PG8_SB(0, 0), b2, voffB); PG8_STAGE(PG8_SB(0, 1), b2 + hstep, voffB); PG8_STAGE(PG8_SA(0, 0), a2, voffA);
            PG8_WAIT_V(8); PG8_WAIT_L(0); PG8_BAR; PG8_MMA(1, 0, At, B0); PG8_MMA(1, 1, At, B1); PG8_BAR; PG8_SCHED;
            PG8_LDB(B0, 1, 0); PG8_LDB(B1, 1, 1); PG8_SCHED; PG8_LDA(At, 1, 0); PG8_STAGE(PG8_SA(0, 1), a2 + hstep, voffA);
            PG8_WAIT_V(8); PG8_WAIT_L(0); PG8_BAR; PG8_MMA(0, 0, At, B0); PG8_MMA(0, 1, At, B1); PG8_BAR; PG8_SCHED;
            PG8_LDA(At, 1, 1); PG8_STAGE(PG8_SB(1, 0), b3, voffB); PG8_STAGE(PG8_SB(1, 1), b3 + hstep, voffB); PG8_STAGE(PG8_SA(1, 0), a3, voffA);
            PG8_WAIT_V(8); PG8_WAIT_L(0); PG8_BAR; PG8_MMA(1, 0, At, B0); PG8_MMA(1, 1, At, B1); PG8_BAR; PG8_SCHED;
            } else {
            PG8_LDB(B0, 0, 0); PG8_SCHED; PG8_LDA(At, 0, 0); PG8_STAGE(PG8_SA(1, 1), a1 + hstep, voffA);
            PG8_WAIT_L(8); PG8_BAR; PG8_WAIT_L(0); PG8_MMA(0, 0, At, B0); PG8_BAR; PG8_SCHED;
            PG8_LDB(B1, 0, 1); PG8_STAGE(PG8_SB(0, 0), b2, voffB);
            PG8_BAR; PG8_WAIT_L(0); PG8_MMA(0, 1, At, B1); PG8_BAR;
            PG8_LDA(At, 0, 1); PG8_STAGE(PG8_SA(0, 0), a2, voffA);
            PG8_BAR; PG8_WAIT_L(0); PG8_MMA(1, 0, At, B0); PG8_BAR; PG8_SCHED;
            PG8_STAGE(PG8_SB(0, 1), b2 + hstep, voffB);
            PG8_WAIT_V(6); PG8_BAR; PG8_MMA(1, 1, At, B1); PG8_BAR;
            PG8_LDB(B0, 1, 0); PG8_SCHED; PG8_LDA(At, 1, 0); PG8_STAGE(PG8_SA(0, 1), a2 + hstep, voffA);
            PG8_WAIT_L(8); PG8_BAR; PG8_WAIT_L(0); PG8_MMA(0, 0, At, B0); PG8_BAR; PG8_SCHED;
            PG8_LDB(B1, 1, 1); PG8_STAGE(PG8_SB(1, 0), b3, voffB);
            PG8_BAR; PG8_WAIT_L(0); PG8_MMA(0, 1, At, B1); PG8_BAR;
            PG8_LDA(At, 1, 1); PG8_STAGE(PG8_SA(1, 0), a3, voffA);
            PG8_BAR; PG8_WAIT_L(0); PG8_MMA(1, 0, At, B0); PG8_BAR; PG8_SCHED;
            PG8_STAGE(PG8_SB(1, 1), b3 + hstep, voffB);
            PG8_WAIT_V(6); PG8_BAR; PG8_MMA(1, 1, At, B1); PG8_BAR;
            }
        }
        if constexpr (ALIGN_EPI) { if (wr == 0) PG8_BAR; }
        if constexpr (!Epi::AFTER_DRAIN) { E(acc, cur, wr, wc, fr, fq); S.done(cur); }
        if (!has_next) break;
#pragma unroll
        for (int a = 0; a < 2; ++a)
#pragma unroll
            for (int b = 0; b < 2; ++b)
#pragma unroll
                for (int m = 0; m < 4; ++m)
#pragma unroll
                    for (int n = 0; n < 2; ++n) acc[a][b][m][n] = (f32x4){0.f, 0.f, 0.f, 0.f};
        cur = nxt; cA = nA; cB = nB; ++ui;
        if constexpr (ALIGN_EPI) { if (wr == 1) PG8_BAR; }
    }
    PG8_WAIT_V(0);
    if constexpr (!ALIGN_EPI) { if (wr == 0) PG8_BAR; }
    PG8_BAR;
    if constexpr (Epi::AFTER_DRAIN) { E.fused(acc, cur, wr, wc, fr, fq, lds, wid, lane); S.done(cur); }
#undef PG8_SA
#undef PG8_SB
#undef PG8_STAGE
#undef PG8_LDA
#undef PG8_LDB
#undef PG8_MMA
#undef PG8_WAIT_V
#undef PG8_WAIT_L
#undef PG8_BAR
#undef PG8_SCHED
}
}
namespace mk {
#define LAS __attribute__((address_space(3)))
typedef unsigned short bf16_t;
typedef short bf16x8 __attribute__((ext_vector_type(8)));
typedef float f32x4 __attribute__((ext_vector_type(4)));
typedef float f32x16 __attribute__((ext_vector_type(16)));
typedef unsigned u32x4 __attribute__((ext_vector_type(4)));
typedef unsigned u32x2 __attribute__((ext_vector_type(2)));
constexpr int NB = 16, SEQ = 2048, DM = 1024, M = NB * SEQ, FF = 2816, NGU = 2 * FF, NIN = 4864, NINA = 2816, DEPTH = 2, INW = 4880;
constexpr int P1W = 2304;
constexpr float EPS = 1e-6f;
constexpr size_t MiB = 1u << 20;
constexpr size_t WS_ROPE = 1 * MiB;
constexpr size_t WS_GATE = 3 * MiB;
constexpr size_t WS_SLOT = 5 * MiB;
constexpr size_t WS_W = 8 * MiB, W_LAYER = 48 * MiB;
constexpr size_t WO_GU1 = 0, WO_D1 = WO_GU1 + (size_t)NGU * DM * 2, WO_IN = WO_D1 + (size_t)DM * FF * 2, WO_A = WO_IN + (size_t)NIN * DM * 2, WO_B = WO_A + (size_t)DM * 512 * 2,
                 WO_O = WO_B + (size_t)DM * 512 * 2, WO_GU2 = WO_O + (size_t)DM * DM * 2, WO_D2 = WO_GU2 + (size_t)NGU * DM * 2, WO_END = WO_D2 + (size_t)DM * FF * 2;
static_assert(WO_END <= W_LAYER, "weights per layer");
constexpr size_t WS_XN = 104 * MiB;
constexpr size_t WS_P1 = 168 * MiB;
constexpr size_t WS_OM = WS_P1 + 144 * MiB;
constexpr size_t WS_YA = WS_OM + 32 * MiB;
constexpr size_t WS_HF = WS_YA + 32 * MiB;
constexpr size_t WS_HB = WS_HF + 32 * MiB;
constexpr size_t WS_END = WS_HB + 32 * MiB;
constexpr int LDS_BYTES = 147456;
constexpr int NSUB = 12, NPHASE = 1 + NSUB * DEPTH;

__device__ __forceinline__ float bf2f(bf16_t h) { return __uint_as_float(((unsigned)h) << 16); }
__device__ __forceinline__ float bflo(unsigned w) { return __uint_as_float(w << 16); }
__device__ __forceinline__ float bfhi(unsigned w) { return __uint_as_float(w & 0xffff0000u); }
__device__ __forceinline__ unsigned pk2(float lo, float hi) { return pg8::cvt_pk_bf16(lo, hi); }
__device__ __forceinline__ bf16_t f2bf(float f) { return (bf16_t)(pk2(f, 0.f) & 0xffffu); }
__device__ __forceinline__ void unpack8(const u32x4 w, float (&x)[8]) { x[0] = bflo(w.x); x[1] = bfhi(w.x); x[2] = bflo(w.y); x[3] = bfhi(w.y); x[4] = bflo(w.z); x[5] = bfhi(w.z); x[6] = bflo(w.w); x[7] = bfhi(w.w); }
__device__ __forceinline__ u32x4 pack8(const float (&x)[8]) { u32x4 w; w.x = pk2(x[0], x[1]); w.y = pk2(x[2], x[3]); w.z = pk2(x[4], x[5]); w.w = pk2(x[6], x[7]); return w; }
__device__ __forceinline__ float sigm(float x) { return __builtin_amdgcn_rcpf(1.0f + __builtin_amdgcn_exp2f(-1.4426950408889634f * x)); }
__device__ __forceinline__ float wave_sum(float v) {
#pragma unroll
    for (int o = 1; o < 64; o <<= 1) v += __shfl_xor(v, o);
    return v;
}
__device__ __forceinline__ int crow(int r, int hi) { return (r & 3) + 8 * (r >> 2) + 4 * hi; }
__device__ __forceinline__ f32x16 mfma32(bf16x8 a, bf16x8 b, f32x16 c) { return __builtin_amdgcn_mfma_f32_32x32x16_bf16(a, b, c, 0, 0, 0); }
#define LDS_WAIT() asm volatile("s_waitcnt lgkmcnt(0)" ::: "memory")

struct Ctx {
    float* X; unsigned char* ws; LAS unsigned char* lds;
    int tid, lane, wave, G, bid;
};

template <int MODE> __device__ __forceinline__ void transpose_item(const float* src0, const float* src1, int K, int Nsrc, bf16_t* WT, LAS float* scr, int item, int nblk, int lane) {
    const int kb = item / nblk, nb = item % nblk, k0 = 64 * kb, n0 = 32 * nb;
    const int np = n0 + (lane & 31); const float* src = src0; int col = np;
    if (MODE == 1) { const int rr = np & 255; src = (rr & 128) ? src1 : src0; col = 128 * (np >> 8) + (rr & 127); }
    if (MODE == 2) { col = np < NINA ? np : np + 16; }
    float tv[32];
#pragma unroll
    for (int i = 0; i < 32; ++i) { const int kk = 2 * i + (lane >> 5); tv[i] = src[(size_t)(k0 + kk) * Nsrc + col]; }
#pragma unroll
    for (int i = 0; i < 32; ++i) { const int kk = 2 * i + (lane >> 5); scr[kk * 33 + (lane & 31)] = tv[i]; }
    LDS_WAIT();
    const int c = lane & 7;
#pragma unroll
    for (int j = 0; j < 4; ++j) { const int n = (lane >> 3) + 8 * j; const LAS float* s = scr + (8 * c) * 33 + n;
        u32x4 o; o.x = pk2(s[0 * 33], s[1 * 33]); o.y = pk2(s[2 * 33], s[3 * 33]); o.z = pk2(s[4 * 33], s[5 * 33]); o.w = pk2(s[6 * 33], s[7 * 33]);
        *(u32x4*)(WT + (size_t)(n0 + n) * K + k0 + 8 * c) = o; }
    LDS_WAIT();
}
__device__ __forceinline__ void prologue_weights(const Ctx& C, const float* w3, const float* w4, const float* w5, const float* w7, const float* w15, const float* w16, const float* w17, const float* w19, const float* w20, const float* w21) {
    LAS float* scr = (LAS float*)(C.lds + C.wave * 8704);
    const int gw = C.bid * 8 + C.wave, NGW = C.G * 8;
    constexpr int I_GU = 16 * (NGU / 32), I_D = (FF / 64) * (DM / 32), I_IN = 16 * (NIN / 32), I_AB = 8 * (DM / 32), I_O = 16 * (DM / 32);
    constexpr int PER = 2 * I_GU + 2 * I_D + I_IN + 2 * I_AB + I_O;
    for (int it = gw; it < DEPTH * PER; it += NGW) {
        const int l = it / PER; int r = it % PER; bf16_t* wl = (bf16_t*)(C.ws + WS_W + (size_t)l * W_LAYER);
        if (r < I_GU) { transpose_item<1>(w3 + (size_t)l * DM * FF, w4 + (size_t)l * DM * FF, DM, FF, (bf16_t*)((unsigned char*)wl + WO_GU1), scr, r, NGU / 32, C.lane); continue; } r -= I_GU;
        if (r < I_D) { transpose_item<0>(w5 + (size_t)l * FF * DM, nullptr, FF, DM, (bf16_t*)((unsigned char*)wl + WO_D1), scr, r, DM / 32, C.lane); continue; } r -= I_D;
        if (r < I_IN) { transpose_item<2>(w7 + (size_t)l * DM * INW, nullptr, DM, INW, (bf16_t*)((unsigned char*)wl + WO_IN), scr, r, NIN / 32, C.lane); continue; } r -= I_IN;
        if (r < I_AB) { transpose_item<0>(w15 + (size_t)l * 512 * DM, nullptr, 512, DM, (bf16_t*)((unsigned char*)wl + WO_A), scr, r, DM / 32, C.lane); continue; } r -= I_AB;
        if (r < I_AB) { transpose_item<0>(w16 + (size_t)l * 512 * DM, nullptr, 512, DM, (bf16_t*)((unsigned char*)wl + WO_B), scr, r, DM / 32, C.lane); continue; } r -= I_AB;
        if (r < I_O) { transpose_item<0>(w17 + (size_t)l * DM * DM, nullptr, DM, DM, (bf16_t*)((unsigned char*)wl + WO_O), scr, r, DM / 32, C.lane); continue; } r -= I_O;
        if (r < I_GU) { transpose_item<1>(w19 + (size_t)l * DM * FF, w20 + (size_t)l * DM * FF, DM, FF, (bf16_t*)((unsigned char*)wl + WO_GU2), scr, r, NGU / 32, C.lane); continue; } r -= I_GU;
        transpose_item<0>(w21 + (size_t)l * FF * DM, nullptr, FF, DM, (bf16_t*)((unsigned char*)wl + WO_D2), scr, r, DM / 32, C.lane);
    }
}
__device__ __forceinline__ void prologue_rope(const Ctx& C, const int* pos) {
 float* rope = (float*)(C.ws + WS_ROPE);
    const float invf[8] = {1.0f, 0.19392274474868576f, 0.03760603093086393f, 0.007292664737217109f, 0.001414213562373095f, 0.0002742481756762073f, 5.318295896944988e-05f, 1.031338537721246e-05f};
    for (int idx = C.bid * 512 + C.tid; idx < M * 8; idx += C.G * 512) {
        const int tok = idx >> 3, i = idx & 7; float f = invf[0];
#pragma unroll
        for (int q = 1; q < 8; ++q) f = (i == q) ? invf[q] : f;
        const float ang = (float)pos[tok] * f;
        const double rev = (double)ang * 0.15915494309189535; const float fr = (float)(rev - floor(rev));
        rope[tok * 16 + i] = __builtin_amdgcn_cosf(fr); rope[tok * 16 + 8 + i] = __builtin_amdgcn_sinf(fr);
    }
}
template <int MODE> __device__ __forceinline__ void norm_pass(const Ctx& C, const float* src, const float* g0, const float* g1, const float* win_l, const float* gbias) {
    bf16_t* XN = (bf16_t*)(C.ws + WS_XN); float* gates = (float*)(C.ws + WS_GATE);
    const bool xl = (C.G == 256); const int lane = C.lane;
    const int gw = xl ? 4096 * (C.bid & 7) + (C.bid >> 3) * 8 + C.wave : C.bid * 8 + C.wave, NGW = xl ? 256 : C.G * 8, rend = xl ? 4096 * ((C.bid & 7) + 1) : M;
    LAS float* Wg = (LAS float*)C.lds;
    if (MODE == 1) {
        for (int idx = C.tid; idx < 1024 * 16; idx += 512) { const int k = idx >> 4, g = idx & 15; const int lp = (k & 255) >> 2, i = k & 3, j = k >> 8;
            Wg[(((j * 4 + i) * 64) + lp) * 20 + g] = win_l[(size_t)k * INW + NINA + g]; }
        __syncthreads();
    }
    f32x4 gv[4];
#pragma unroll
    for (int j = 0; j < 4; ++j) gv[j] = ((const f32x4*)g0)[lane + 64 * j];
    f32x4 nv[4];
    if (gw < rend) { const f32x4* xr0 = (const f32x4*)(src + (size_t)gw * DM) + lane;
#pragma unroll
        for (int j = 0; j < 4; ++j) nv[j] = xr0[64 * j]; }
    for (int row = gw; row < rend; row += NGW) {
        f32x4 v[4]; float ss = 0.f;
#pragma unroll
        for (int j = 0; j < 4; ++j) v[j] = nv[j];
        if (row + NGW < rend) { const f32x4* xr1 = (const f32x4*)(src + (size_t)(row + NGW) * DM) + lane;
#pragma unroll
            for (int j = 0; j < 4; ++j) nv[j] = xr1[64 * j]; }
#pragma unroll
        for (int j = 0; j < 4; ++j) ss += (v[j].x * v[j].x + v[j].y * v[j].y) + (v[j].z * v[j].z + v[j].w * v[j].w);
        const float rstd = rsqrtf(wave_sum(ss) * (1.0f / DM) + EPS);
#pragma unroll
        for (int j = 0; j < 4; ++j) v[j] = v[j] * rstd * gv[j];
        if (MODE == 3) {
            f32x4* xo = (f32x4*)(C.X + (size_t)row * DM) + lane;
#pragma unroll
            for (int j = 0; j < 4; ++j) xo[64 * j] = v[j];
            if (g1 == nullptr) continue;
            float s2 = 0.f;
#pragma unroll
            for (int j = 0; j < 4; ++j) s2 += (v[j].x * v[j].x + v[j].y * v[j].y) + (v[j].z * v[j].z + v[j].w * v[j].w);
            const float r2 = rsqrtf(wave_sum(s2) * (1.0f / DM) + EPS);
#pragma unroll
            for (int j = 0; j < 4; ++j) v[j] = v[j] * r2 * ((const f32x4*)g1)[lane + 64 * j];
        }
        u32x2* o8 = (u32x2*)(XN + (size_t)row * DM) + lane;
#pragma unroll
        for (int j = 0; j < 4; ++j) { u32x2 w; w.x = pk2(v[j].x, v[j].y); w.y = pk2(v[j].z, v[j].w); o8[64 * j] = w; }
        if (MODE == 1) {
            float ga[16];
#pragma unroll
            for (int g = 0; g < 16; ++g) ga[g] = 0.f;
#pragma unroll
            for (int j = 0; j < 4; ++j)
#pragma unroll
                for (int i = 0; i < 4; ++i) { const float xv = v[j][i]; const LAS f32x4* wp = (const LAS f32x4*)(Wg + (((j * 4 + i) * 64) + lane) * 20);
#pragma unroll
                    for (int q = 0; q < 4; ++q) { const f32x4 w = wp[q]; ga[4 * q] += xv * w.x; ga[4 * q + 1] += xv * w.y; ga[4 * q + 2] += xv * w.z; ga[4 * q + 3] += xv * w.w; } }
            const bool b5 = (lane & 32) != 0, b4 = (lane & 16) != 0, b3 = (lane & 8) != 0, b2 = (lane & 4) != 0;
            float g8[8], g4[4], g2[2];
#pragma unroll
            for (int i = 0; i < 8; ++i) { const float mine = b5 ? ga[8 + i] : ga[i], oth = b5 ? ga[i] : ga[8 + i]; g8[i] = mine + __shfl_xor(oth, 32); }
#pragma unroll
            for (int i = 0; i < 4; ++i) { const float mine = b4 ? g8[4 + i] : g8[i], oth = b4 ? g8[i] : g8[4 + i]; g4[i] = mine + __shfl_xor(oth, 16); }
#pragma unroll
            for (int i = 0; i < 2; ++i) { const float mine = b3 ? g4[2 + i] : g4[i], oth = b3 ? g4[i] : g4[2 + i]; g2[i] = mine + __shfl_xor(oth, 8); }
            float g1 = (b2 ? g2[1] : g2[0]) + __shfl_xor(b2 ? g2[0] : g2[1], 4);
            g1 += __shfl_xor(g1, 2); g1 += __shfl_xor(g1, 1);
            if ((lane & 3) == 0) { const int g = (b5 ? 8 : 0) + (b4 ? 4 : 0) + (b3 ? 2 : 0) + (b2 ? 1 : 0); gates[(size_t)row * 16 + g] = g1 + gbias[g]; }
        }
    }
}
__device__ __forceinline__ void mc_pass(const Ctx& C, const float* ng) {
    bf16_t* HF = (bf16_t*)(C.ws + WS_HF); const bf16_t* HB = (const bf16_t*)(C.ws + WS_HB); const bf16_t* OM = (const bf16_t*)(C.ws + WS_OM);
    const bool xl = (C.G == 256); const int lane = C.lane;
    const int gw = xl ? 4096 * (C.bid & 7) + (C.bid >> 3) * 8 + C.wave : C.bid * 8 + C.wave, NGW = xl ? 256 : C.G * 8, rend = xl ? 4096 * ((C.bid & 7) + 1) : M;
    const f32x4 g0 = ((const f32x4*)ng)[2 * lane], g1 = ((const f32x4*)ng)[2 * lane + 1];
    const float gg[8] = {g0.x, g0.y, g0.z, g0.w, g1.x, g1.y, g1.z, g1.w};
    for (int row = gw; row < rend; row += NGW) {
        const size_t off = (size_t)row * 512 + 8 * lane;
        float a[8], b[8], o[8]; unpack8(*(const u32x4*)(HF + off), a); unpack8(*(const u32x4*)(HB + off), b); unpack8(*(const u32x4*)(OM + off), o);
        float s = 0.f;
#pragma unroll
        for (int i = 0; i < 8; ++i) { a[i] += b[i]; s += a[i]; }
        s += __shfl_xor(s, 1); s += __shfl_xor(s, 2); s += __shfl_xor(s, 4); s += __shfl_xor(s, 8);
        const float mu = s * (1.0f / 128.0f); float q = 0.f;
#pragma unroll
        for (int i = 0; i < 8; ++i) { a[i] -= mu; q += a[i] * a[i]; }
        q += __shfl_xor(q, 1); q += __shfl_xor(q, 2); q += __shfl_xor(q, 4); q += __shfl_xor(q, 8);
        const float rs = rsqrtf(q * (1.0f / 128.0f) + EPS);
#pragma unroll
        for (int i = 0; i < 8; ++i) a[i] = a[i] * rs * gg[i] * sigm(o[i]);
        *(u32x4*)(HF + off) = pack8(a);
    }
}
constexpr int AT_KROW = 144, AT_VROW = 776, AT_K_OFF = 0, AT_V_OFF = 384 * AT_KROW, AT_END = AT_V_OFF + 64 * AT_VROW;
static_assert(AT_END <= LDS_BYTES, "attention LDS");
__device__ __forceinline__ void attn_unit(const Ctx& C, int unit, const float* gq, const float* gk, const float* sink) {
    const bf16_t* P1 = (const bf16_t*)(C.ws + WS_P1); const float* rope = (const float*)(C.ws + WS_ROPE); bf16_t* YA = (bf16_t*)(C.ws + WS_YA);
    LAS unsigned char* lds = C.lds; const int tid = C.tid, lane = C.lane, wave = C.wave, hi = lane >> 5, l31 = lane & 31;
    const int b = unit >> 5, kvh = (unit >> 4) & 1, n = unit & 15;
    const size_t tokb = (size_t)b * SEQ; const int kpos0 = (n - 1) * 128;
    {
        const int p = tid & 7;
        const f32x4 ga = ((const f32x4*)gk)[2 * p], gb = ((const f32x4*)gk)[2 * p + 1];
        const float gkk[8] = {ga.x, ga.y, ga.z, ga.w, gb.x, gb.y, gb.z, gb.w};
#pragma unroll 2
        for (int it = 0; it < 6; ++it) {
            const int j = (tid >> 3) + 64 * it; const int kp = kpos0 + j; const bool ok = (kp >= 0) && (kp < SEQ);
            u32x4 kraw = (u32x4){0u, 0u, 0u, 0u}, vraw = (u32x4){0u, 0u, 0u, 0u}; f32x4 c0 = (f32x4){0.f, 0.f, 0.f, 0.f}, c1 = c0, s0 = c0, s1 = c0;
            if (ok) { const bf16_t* rp = P1 + (tokb + kp) * P1W; kraw = *(const u32x4*)(rp + 512 + kvh * 64 + p * 8); vraw = *(const u32x4*)(rp + 640 + kvh * 64 + p * 8);
                if (p < 2) { const f32x4* rt = (const f32x4*)(rope + (tokb + kp) * 16); c0 = rt[0]; c1 = rt[1]; s0 = rt[2]; s1 = rt[3]; } }
            float x[8]; unpack8(kraw, x); float ss = 0.f;
#pragma unroll
            for (int i = 0; i < 8; ++i) ss += x[i] * x[i];
            ss += SHX(ss, 1, lane); ss += SHX(ss, 2, lane); ss += SHX(ss, 4, lane);
            const float rstd = rsqrtf(ss * (1.0f / 64.0f) + EPS);
            const float cs[8] = {c0.x, c0.y, c0.z, c0.w, c1.x, c1.y, c1.z, c1.w}, sn[8] = {s0.x, s0.y, s0.z, s0.w, s1.x, s1.y, s1.z, s1.w};
#pragma unroll
            for (int i = 0; i < 8; ++i) { const float y = x[i] * rstd * gkk[i]; const float pr = SHX(y, 1, lane);
                x[i] = (p == 0) ? (y * cs[i] - pr * sn[i]) : ((p == 1) ? (y * cs[i] + pr * sn[i]) : y); }
            *(LAS u32x4*)(lds + AT_K_OFF + j * AT_KROW + p * 16) = pack8(x);
            const unsigned vw[4] = {vraw.x, vraw.y, vraw.z, vraw.w};
#pragma unroll
            for (int i = 0; i < 8; ++i) { const bf16_t e = (bf16_t)((i & 1) ? (vw[i >> 1] >> 16) : (vw[i >> 1] & 0xffffu)); *(LAS bf16_t*)(lds + AT_V_OFF + (p * 8 + i) * AT_VROW + j * 2) = e; }
        }
    }
    __syncthreads();
    const int g = wave >> 1, hq = kvh * 4 + g;
    const float sinkL = sink[hq] * 1.4426950408889634f;
    const int jlo = (n == 0) ? 128 : 0, jhi = (n == 15) ? 256 : 384;
    for (int sub = 0; sub < 2; ++sub) {
        const int q0 = (wave & 1) * 64 + sub * 32, qi = q0 + l31; const size_t tq = tokb + n * 128 + qi;
        bf16x8 qf[4];
        {
            float x[4][8]; float ss = 0.f; const bf16_t* rp = P1 + tq * P1W + hq * 64 + 8 * hi;
#pragma unroll
            for (int ks = 0; ks < 4; ++ks) { unpack8(*(const u32x4*)(rp + 16 * ks), x[ks]);
#pragma unroll
                for (int i = 0; i < 8; ++i) ss += x[ks][i] * x[ks][i]; }
            ss += SHX(ss, 32, lane);
            const float rstd = rsqrtf(ss * (1.0f / 64.0f) + EPS);
            const f32x4* rt = (const f32x4*)(rope + tq * 16); const f32x4 c0 = rt[0], c1 = rt[1], s0 = rt[2], s1 = rt[3];
            const float cs[8] = {c0.x, c0.y, c0.z, c0.w, c1.x, c1.y, c1.z, c1.w}, sn[8] = {s0.x, s0.y, s0.z, s0.w, s1.x, s1.y, s1.z, s1.w};
            constexpr float QS = 0.125f * 1.4426950408889634f;
#pragma unroll
            for (int ks = 0; ks < 4; ++ks) { const f32x4 ga = *(const f32x4*)(gq + 16 * ks + 8 * hi), gb = *(const f32x4*)(gq + 16 * ks + 8 * hi + 4);
                const float gg[8] = {ga.x, ga.y, ga.z, ga.w, gb.x, gb.y, gb.z, gb.w};
#pragma unroll
                for (int i = 0; i < 8; ++i) x[ks][i] = x[ks][i] * rstd * gg[i]; }
#pragma unroll
            for (int i = 0; i < 8; ++i) { const float y = x[0][i]; const float pr = SHX(y, 32, lane); x[0][i] = (hi == 0) ? (y * cs[i] - pr * sn[i]) : (y * cs[i] + pr * sn[i]); }
#pragma unroll
            for (int ks = 0; ks < 4; ++ks) {
#pragma unroll
                for (int i = 0; i < 8; ++i) x[ks][i] *= QS;
                qf[ks] = __builtin_bit_cast(bf16x8, pack8(x[ks])); }
        }
        float mrun = sinkL, lsum = 0.f; f32x16 o0, o1;
#pragma unroll
        for (int r = 0; r < 16; ++r) { o0[r] = 0.f; o1[r] = 0.f; }
        for (int t = 0; t < 6; ++t) {
            const int j0 = 64 * t;
            if (j0 + 63 < q0 || j0 > q0 + 31 + 256 || j0 + 63 < jlo || j0 >= jhi) continue;
            f32x16 p0, p1;
#pragma unroll
            for (int r = 0; r < 16; ++r) { p0[r] = 0.f; p1[r] = 0.f; }
#pragma unroll
            for (int ks = 0; ks < 4; ++ks) {
                const bf16x8 a0 = *(const LAS bf16x8*)(lds + AT_K_OFF + (j0 + l31) * AT_KROW + (16 * ks + 8 * hi) * 2);
                const bf16x8 a1 = *(const LAS bf16x8*)(lds + AT_K_OFF + (j0 + 32 + l31) * AT_KROW + (16 * ks + 8 * hi) * 2);
                p0 = mfma32(a0, qf[ks], p0); p1 = mfma32(a1, qf[ks], p1);
            }
            float mx = -INFINITY;
            const bool interior = (j0 >= jlo) && (j0 + 64 <= jhi) && (j0 >= q0 + 31) && (j0 + 63 <= q0 + 256);
            if (interior) {
#pragma unroll
                for (int r = 0; r < 16; ++r) mx = fmaxf(mx, fmaxf(p0[r], p1[r]));
            } else {
#pragma unroll
                for (int r = 0; r < 16; ++r) { const int ja = j0 + crow(r, hi), jb = ja + 32;
                    const bool va = (ja >= qi) && (ja <= qi + 256) && (ja >= jlo) && (ja < jhi), vb = (jb >= qi) && (jb <= qi + 256) && (jb >= jlo) && (jb < jhi);
                    p0[r] = va ? p0[r] : -INFINITY; p1[r] = vb ? p1[r] : -INFINITY; mx = fmaxf(mx, fmaxf(p0[r], p1[r])); }
            }
            mx = fmaxf(mx, SHX(mx, 32, lane));
            if (__builtin_amdgcn_ballot_w64(mx > mrun + 8.0f) != 0ull) {
                const float mnew = fmaxf(mrun, mx), alpha = __builtin_amdgcn_exp2f(mrun - mnew); mrun = mnew; lsum *= alpha;
#pragma unroll
                for (int r = 0; r < 16; ++r) { o0[r] *= alpha; o1[r] *= alpha; }
            }
            float ps = 0.f;
#pragma unroll
            for (int r = 0; r < 16; ++r) { p0[r] = __builtin_amdgcn_exp2f(p0[r] - mrun); p1[r] = __builtin_amdgcn_exp2f(p1[r] - mrun); ps += p0[r] + p1[r]; }
            lsum += ps;
#pragma unroll
            for (int s = 0; s < 4; ++s) {
                u32x4 pw;
                if (s == 0) pw = (u32x4){pk2(p0[0], p0[1]), pk2(p0[2], p0[3]), pk2(p0[4], p0[5]), pk2(p0[6], p0[7])};
                else if (s == 1) pw = (u32x4){pk2(p0[8], p0[9]), pk2(p0[10], p0[11]), pk2(p0[12], p0[13]), pk2(p0[14], p0[15])};
                else if (s == 2) pw = (u32x4){pk2(p1[0], p1[1]), pk2(p1[2], p1[3]), pk2(p1[4], p1[5]), pk2(p1[6], p1[7])};
                else pw = (u32x4){pk2(p1[8], p1[9]), pk2(p1[10], p1[11]), pk2(p1[12], p1[13]), pk2(p1[14], p1[15])};
                const bf16x8 pf = __builtin_bit_cast(bf16x8, pw);
                const int kb = j0 + 16 * s + 4 * hi;
                {   const LAS unsigned char* vp = lds + AT_V_OFF + l31 * AT_VROW + kb * 2;
                    const u32x2 lo = *(const LAS u32x2*)vp, hh = *(const LAS u32x2*)(vp + 16);
                    o0 = mfma32(__builtin_bit_cast(bf16x8, (u32x4){lo.x, lo.y, hh.x, hh.y}), pf, o0); }
                {   const LAS unsigned char* vp = lds + AT_V_OFF + (32 + l31) * AT_VROW + kb * 2;
                    const u32x2 lo = *(const LAS u32x2*)vp, hh = *(const LAS u32x2*)(vp + 16);
                    o1 = mfma32(__builtin_bit_cast(bf16x8, (u32x4){lo.x, lo.y, hh.x, hh.y}), pf, o1); }
            }
        }
        const float ltot = lsum + SHX(lsum, 32, lane) + __builtin_amdgcn_exp2f(sinkL - mrun);
        const float inv = 1.0f / ltot;
        bf16_t* op = YA + tq * 512 + hq * 64 + 4 * hi;
#pragma unroll
        for (int rq = 0; rq < 4; ++rq) {
            u32x2 w0; w0.x = pk2(o0[4 * rq] * inv, o0[4 * rq + 1] * inv); w0.y = pk2(o0[4 * rq + 2] * inv, o0[4 * rq + 3] * inv); *(u32x2*)(op + 8 * rq) = w0;
            u32x2 w1; w1.x = pk2(o1[4 * rq] * inv, o1[4 * rq + 1] * inv); w1.y = pk2(o1[4 * rq + 2] * inv, o1[4 * rq + 3] * inv); *(u32x2*)(op + 32 + 8 * rq) = w1;
        }
    }
    __syncthreads();
}
constexpr int ML_ROW = 272;
constexpr int ML_Q = 0, ML_K = 128 * ML_ROW, ML_V = 2 * 128 * ML_ROW, ML_C = ML_V + 64 * ML_ROW, ML_SM = ML_C + 64 * ML_ROW;
constexpr int ML_SET = 2112;
constexpr int ML_N = ML_SM + 16 * ML_SET, ML_CW = ML_N + 512, ML_END = ML_CW + 4096;
static_assert(ML_END <= LDS_BYTES - 64, "mLSTM LDS");
__device__ __forceinline__ float logsig(float x) { const float ax = fabsf(x); return fminf(x, 0.f) - __logf(1.0f + __expf(-ax)); }
__device__ __forceinline__ void mlstm_chain(const Ctx& C, int chain, const float* cw, const float* cb) {
    const bf16_t* P1 = (const bf16_t*)(C.ws + WS_P1); const float* gates = (const float*)(C.ws + WS_GATE);
    const int b = chain >> 4, h = (chain >> 2) & 3, dir = (chain >> 1) & 1, half = chain & 1;
    bf16_t* HO = (bf16_t*)(C.ws + (dir ? WS_HB : WS_HF));
    LAS unsigned char* lds = C.lds; const int tid = C.tid, lane = C.lane, wave = C.wave, hi = lane >> 5, l31 = lane & 31;
    const size_t tokb = (size_t)b * SEQ;
    LAS float* nF = (LAS float*)(lds + ML_N); LAS float* cwS = (LAS float*)(lds + ML_CW);
    f32x16 cacc0;
#pragma unroll
    for (int r = 0; r < 16; ++r) cacc0[r] = 0.f;
    for (int i = tid; i < 64 * ML_ROW / 4; i += 512) ((LAS unsigned*)(lds + ML_C))[i] = 0u;
    if (tid < 128) nF[tid] = 0.f;
    for (int i = tid; i < 1024; i += 512) { const int qk = i >> 9, j = (i >> 7) & 3, d = i & 127; const int ch = qk * 512 + h * 128 + d; cwS[i] = (j < 3) ? cw[j * 1024 + ch] : cb[ch]; }
    float m_state = 0.f;
    const int gi = (dir ? 2 : 0) * 4 + h, gf = (dir ? 3 : 1) * 4 + h;
    const int dvh = wave >> 2, tb = dvh ? 3 - (wave & 3) : (wave & 3);
    const int dkb = wave & 3, dvq = wave >> 2;
    const int p = tid & 15, jb = (tid >> 4) * 4, chq = h * 128 + p * 8, pv = p & 7, kv0 = (p >> 3) * 2;
    u32x4 rq[6], rk[6], rv[2]; float gl0 = 0.f, gl1 = 0.f, gf0 = 0.f, gf1 = 0.f;
    const u32x4 z4 = (u32x4){0u, 0u, 0u, 0u};
#define ML_LOAD_RAW(STEP) do { const int cc_ = dir ? 15 - (STEP) : (STEP); const int pb_ = cc_ * 128; const int pl_ = dir ? pb_ + 124 - jb : pb_ + jb; \
        _Pragma("unroll") for (int k = 0; k < 6; ++k) { const int pos = pl_ - 1 + k; const bool ok = (pos >= 0) && (pos < SEQ); const bf16_t* r0 = P1 + (tokb + pos) * P1W; \
            rq[k] = ok ? *(const u32x4*)(r0 + 768 + chq) : z4; rk[k] = ok ? *(const u32x4*)(r0 + 1280 + chq) : z4; } \
        _Pragma("unroll") for (int k = 0; k < 2; ++k) rv[k] = *(const u32x4*)(P1 + (tokb + pl_ + kv0 + k) * P1W + 1792 + h * 128 + half * 64 + pv * 8); } while (0)
#define ML_LOAD_GATES(STEP) do { const int cc_ = dir ? 15 - (STEP) : (STEP); const int pb_ = cc_ * 128; const int pa = dir ? pb_ + 127 - lane : pb_ + lane, pc = dir ? pb_ + 63 - lane : pb_ + 64 + lane; \
        const float* ga = gates + (tokb + pa) * 16; const float* gb = gates + (tokb + pc) * 16; gl0 = ga[gi]; gf0 = ga[gf]; gl1 = gb[gi]; gf1 = gb[gf]; } while (0)
#define ML_SCAN(SETP) do { LAS float* uS_ = (LAS float*)(SETP); LAS float* pmS_ = uS_ + 128; LAS float* btS_ = uS_ + 256; LAS float* wS_ = uS_ + 384; LAS float* sc_ = uS_ + 512; \
        const int j0 = lane, j1 = lane + 64; float v0 = logsig(gf0), v1 = logsig(gf1); \
        _Pragma("unroll") for (int o = 1; o < 64; o <<= 1) { const float t0 = __int_as_float(__builtin_amdgcn_ds_bpermute(((lane >= o ? lane - o : lane) << 2), __float_as_int(v0))), t1 = __int_as_float(__builtin_amdgcn_ds_bpermute(((lane >= o ? lane - o : lane) << 2), __float_as_int(v1))); if (lane >= o) { v0 += t0; v1 += t1; } } \
        v1 += __int_as_float(__builtin_amdgcn_readlane(__float_as_int(v0), 63)); \
        const float u0 = gl0 - v0, u1 = gl1 - v1; float m0 = u0, m1 = u1; \
        _Pragma("unroll") for (int o = 1; o < 64; o <<= 1) { const float t0 = __int_as_float(__builtin_amdgcn_ds_bpermute(((lane >= o ? lane - o : lane) << 2), __float_as_int(m0))), t1 = __int_as_float(__builtin_amdgcn_ds_bpermute(((lane >= o ? lane - o : lane) << 2), __float_as_int(m1))); if (lane >= o) { m0 = fmaxf(m0, t0); m1 = fmaxf(m1, t1); } } \
        m1 = fmaxf(m1, __int_as_float(__builtin_amdgcn_readlane(__float_as_int(m0), 63))); \
        btS_[j0] = v0; btS_[j1] = v1; uS_[j0] = u0; uS_[j1] = u1; pmS_[j0] = m0; pmS_[j1] = m1; \
        if (lane == 63) { sc_[0] = v1; sc_[1] = m1; } \
        const float pml_ = __int_as_float(__builtin_amdgcn_readlane(__float_as_int(m1), 63)); \
        wS_[j0] = __expf(u0 - pml_); wS_[j1] = __expf(u1 - pml_); } while (0)
    ML_LOAD_RAW(0);
    for (int q = 0; q < 2; ++q) { const int st_ = 2 * wave + q; ML_LOAD_GATES(st_); ML_SCAN(lds + ML_SM + st_ * ML_SET); }
    __syncthreads();
    for (int step = 0; step < 16; ++step) {
        const int cc = dir ? 15 - step : step; const int pbase = cc * 128;
        LAS float* uS = (LAS float*)(lds + ML_SM + step * ML_SET); LAS float* pmS = uS + 128; LAS float* btS = uS + 256; LAS float* wS = uS + 384; LAS float* scal = uS + 512;
        {
#pragma unroll
            for (int qk = 0; qk < 2; ++qk) {
                float w0[8], w1[8], w2[8], bb[8]; const LAS float* cwp = cwS + qk * 512 + p * 8;
#pragma unroll
                for (int hf = 0; hf < 2; ++hf) {
                    const f32x4 a0 = *(const LAS f32x4*)(cwp + 4 * hf), a1 = *(const LAS f32x4*)(cwp + 128 + 4 * hf), a2 = *(const LAS f32x4*)(cwp + 256 + 4 * hf), a3 = *(const LAS f32x4*)(cwp + 384 + 4 * hf);
#pragma unroll
                    for (int i = 0; i < 4; ++i) { w0[4 * hf + i] = a0[i]; w1[4 * hf + i] = a1[i]; w2[4 * hf + i] = a2[i]; bb[4 * hf + i] = a3[i]; }
                }
                const float osc = qk ? 0.08838834764831845f : 1.0f; LAS unsigned char* dst = lds + (qk ? ML_K : ML_Q) + p * 16;
                float um[8], u0[8], up[8]; unpack8(qk ? rk[0] : rq[0], um); unpack8(qk ? rk[1] : rq[1], u0);
#pragma unroll
                for (int k = 0; k < 4; ++k) {
                    unpack8(qk ? rk[k + 2] : rq[k + 2], up);
                    float y[8];
#pragma unroll
                    for (int i = 0; i < 8; ++i) { const float a = um[i] * w0[i] + u0[i] * w1[i] + up[i] * w2[i] + bb[i]; y[i] = a * sigm(a) * osc; um[i] = u0[i]; u0[i] = up[i]; }
                    const int j = dir ? jb + 3 - k : jb + k;
                    *(LAS u32x4*)(dst + j * ML_ROW) = pack8(y);
                }
                __builtin_amdgcn_sched_barrier(0);
            }
#pragma unroll
            for (int k = 0; k < 2; ++k) { const int kk = kv0 + k; const int j = dir ? jb + 3 - kk : jb + kk; const unsigned vw[4] = {rv[k].x, rv[k].y, rv[k].z, rv[k].w};
#pragma unroll
                for (int i = 0; i < 8; ++i) { const bf16_t e2 = (bf16_t)((i & 1) ? (vw[i >> 1] >> 16) : (vw[i >> 1] & 0xffffu)); *(LAS bf16_t*)(lds + ML_V + (pv * 8 + i) * ML_ROW + j * 2) = e2; } }
        }
        __syncthreads();
        if (step < 15) { ML_LOAD_RAW(step + 1); }
        const float btot = scal[0], pml = scal[1];
        const float m_in = m_state, a_max = btot + pml, m_new = fmaxf(btot + m_in, a_max);
        const float s_p = __expf(btot + m_in - m_new), s_l = __expf(a_max - m_new);
        {
            const int t = 32 * tb + l31;
            bf16x8 qf[8];
#pragma unroll
            for (int ks = 0; ks < 8; ++ks) qf[ks] = *(const LAS bf16x8*)(lds + ML_Q + t * ML_ROW + (16 * ks + 8 * hi) * 2);
            const float Mt = fmaxf(m_in, pmS[t]), bt = btS[t];
            const float scale_in = __expf(m_in - Mt);
            float qn = 0.f;
#pragma unroll
            for (int ks = 0; ks < 8; ++ks) { float qv[8]; unpack8(__builtin_bit_cast(u32x4, qf[ks]), qv); const LAS f32x4* np = (const LAS f32x4*)(nF + 16 * ks + 8 * hi); const f32x4 n0 = np[0], n1 = np[1];
                qn += qv[0] * n0.x + qv[1] * n0.y + qv[2] * n0.z + qv[3] * n0.w + qv[4] * n1.x + qv[5] * n1.y + qv[6] * n1.z + qv[7] * n1.w; }
            qn += SHX(qn, 32, lane);
            f32x16 oa0;
#pragma unroll
            for (int r = 0; r < 16; ++r) oa0[r] = 0.f;
            const int dv0 = 32 * dvh + l31;
#pragma unroll
            for (int ks = 0; ks < 8; ++ks) { const bf16x8 c0 = *(const LAS bf16x8*)(lds + ML_C + dv0 * ML_ROW + (16 * ks + 8 * hi) * 2); oa0 = mfma32(c0, qf[ks], oa0); }
#pragma unroll
            for (int r = 0; r < 16; ++r) oa0[r] *= scale_in;
            float dsum = 0.f;
            for (int sb = 0; sb <= tb; ++sb) {
                f32x16 st;
#pragma unroll
                for (int r = 0; r < 16; ++r) st[r] = 0.f;
#pragma unroll
                for (int ks = 0; ks < 8; ++ks) { const bf16x8 kf = *(const LAS bf16x8*)(lds + ML_K + (32 * sb + l31) * ML_ROW + (16 * ks + 8 * hi) * 2); st = mfma32(kf, qf[ks], st); }
#pragma unroll
                for (int r = 0; r < 16; ++r) { const int s = 32 * sb + crow(r, hi); const float pw = __expf(uS[s] - Mt); const float v = (s <= t) ? st[r] * pw : 0.f; st[r] = v; dsum += v; }
#pragma unroll
                for (int s2 = 0; s2 < 2; ++s2) {
                    const u32x4 pw = (s2 == 0) ? (u32x4){pk2(st[0], st[1]), pk2(st[2], st[3]), pk2(st[4], st[5]), pk2(st[6], st[7])} : (u32x4){pk2(st[8], st[9]), pk2(st[10], st[11]), pk2(st[12], st[13]), pk2(st[14], st[15])};
                    const bf16x8 pf = __builtin_bit_cast(bf16x8, pw);
                    const int kb = 32 * sb + 16 * s2 + 4 * hi;
                    const LAS unsigned char* vp = lds + ML_V + dv0 * ML_ROW + kb * 2; const u32x2 lo = *(const LAS u32x2*)vp, hh = *(const LAS u32x2*)(vp + 16);
                    oa0 = mfma32(__builtin_bit_cast(bf16x8, (u32x4){lo.x, lo.y, hh.x, hh.y}), pf, oa0);
                }
            }
            const float den = dsum + SHX(dsum, 32, lane) + scale_in * qn;
            const float dd = fmaxf(fabsf(den), __expf(-(bt + Mt))); const float inv = 1.0f / dd;
            const int pos = dir ? pbase + 127 - t : pbase + t;
            bf16_t* op = HO + (tokb + pos) * 512 + h * 128 + half * 64 + 32 * dvh + 4 * hi;
#pragma unroll
            for (int rq2 = 0; rq2 < 4; ++rq2) { u32x2 w0; w0.x = pk2(oa0[4 * rq2] * inv, oa0[4 * rq2 + 1] * inv); w0.y = pk2(oa0[4 * rq2 + 2] * inv, oa0[4 * rq2 + 3] * inv); *(u32x2*)(op + 8 * rq2) = w0; }
        }
        __syncthreads();
        {
#pragma unroll
            for (int r = 0; r < 16; ++r) cacc0[r] *= s_p;
            float nsum = 0.f;
            const int dk = 32 * dkb + l31, dv0 = 32 * dvq + l31;
#pragma unroll
            for (int ks = 0; ks < 8; ++ks) {
                float kw[8]; const LAS f32x4* wp = (const LAS f32x4*)(wS + 16 * ks + 8 * hi); const f32x4 wa = wp[0], wb = wp[1]; const float ww[8] = {wa.x * s_l, wa.y * s_l, wa.z * s_l, wa.w * s_l, wb.x * s_l, wb.y * s_l, wb.z * s_l, wb.w * s_l};
                bf16_t kr[8];
#pragma unroll
                for (int i = 0; i < 8; ++i) { const int s = 16 * ks + 8 * hi + i; kr[i] = *(const LAS bf16_t*)(lds + ML_K + s * ML_ROW + dk * 2); }
                __builtin_amdgcn_sched_barrier(0);
#pragma unroll
                for (int i = 0; i < 8; ++i) { kw[i] = bf2f(kr[i]) * ww[i]; nsum += kw[i]; }
                const bf16x8 bfr = __builtin_bit_cast(bf16x8, pack8(kw));
                const bf16x8 a0 = *(const LAS bf16x8*)(lds + ML_V + dv0 * ML_ROW + (16 * ks + 8 * hi) * 2);
                cacc0 = mfma32(a0, bfr, cacc0);
            }
            nsum += SHX(nsum, 32, lane);
            if (dvq == 0 && hi == 0) nF[dk] = s_p * nF[dk] + nsum;
#pragma unroll
            for (int r = 0; r < 16; ++r) *(LAS bf16_t*)(lds + ML_C + (32 * dvq + crow(r, hi)) * ML_ROW + dk * 2) = f2bf(cacc0[r]);
            m_state = m_new;
        }
        __syncthreads();
    }
#undef ML_LOAD_RAW
#undef ML_LOAD_GATES
#undef ML_SCAN
}
#define XB_TMO      128
#define XB_XCNT(j)  (256  + 64 * (j))
#define XB_XSUB(j)  (1280 + 64 * (j))
#define XB_XGEN(j)  (2304 + 64 * (j))
#define XB_TOP      3328
#define XB_TOPGEN   3392
#define XCD_BAR_WORDS 3456
#define XB_SPIN_CAP (1u << 18)

__device__ __forceinline__ unsigned xb_ld(unsigned* p)              { return __hip_atomic_load(p, __ATOMIC_RELAXED, __HIP_MEMORY_SCOPE_AGENT); }
__device__ __forceinline__ unsigned xb_add(unsigned* p, unsigned v) { return __hip_atomic_fetch_add(p, v, __ATOMIC_RELAXED, __HIP_MEMORY_SCOPE_AGENT); }
__device__ __forceinline__ unsigned xb_xcc_id() { return (unsigned)__builtin_amdgcn_s_getreg((3 << 11) | 20) & 0xFu; }
#define XB_SPIN(cond, bar) do { unsigned _sp = 0; while (cond) { __builtin_amdgcn_s_sleep(1); \
    if ((++_sp & 255u) == 0u) { if (xb_ld(&(bar)[XB_TMO])) break; if (_sp > XB_SPIN_CAP) { atomicAdd(&(bar)[XB_TMO], 1u); break; } } } } while (0)

struct XcdBarrier {
    unsigned* bar; unsigned x;
    volatile LAS unsigned* st;
};

__device__ __forceinline__ XcdBarrier xcd_barrier_post(unsigned* bar, volatile LAS unsigned* st) {
    XcdBarrier b; b.bar = bar; b.x = xb_xcc_id(); b.st = st;
    if (threadIdx.x == 0) (void)xb_add(&bar[XB_XCNT(b.x)], 1u);
    return b;
}
__device__ __forceinline__ void xcd_barrier_complete(unsigned* bar, unsigned x, unsigned& nloc, unsigned& nx) {
    const unsigned G = gridDim.x * gridDim.y * gridDim.z;
    unsigned sum, cnt, mine, sp = 0u;
    for (;;) {
        sum = 0u; cnt = 0u; mine = 0u;
#pragma unroll
        for (unsigned j = 0; j < 16; ++j) { const unsigned c = xb_ld(&bar[XB_XCNT(j)]); sum += c; cnt += (c > 0u) ? 1u : 0u; mine = (j == x) ? c : mine; }
        if (sum == G) break;
        __builtin_amdgcn_s_sleep(1);
        if ((++sp & 255u) == 0u) { if (xb_ld(&bar[XB_TMO])) break; if (sp > XB_SPIN_CAP) { atomicAdd(&bar[XB_TMO], 1u); break; } }
    }
    nloc = mine > 0u ? mine : 1u; nx = cnt > 0u ? cnt : 1u;
}

__device__ __forceinline__ void xcd_barrier(const XcdBarrier& b) {
    asm volatile("s_waitcnt vmcnt(0)" ::: "memory");
    __syncthreads();
    if (threadIdx.x == 0) {
        unsigned* bar = b.bar;
        __builtin_amdgcn_s_waitcnt(0);
        unsigned nloc = b.st[0], nx = b.st[1];
        if (nloc == 0u) { xcd_barrier_complete(bar, b.x, nloc, nx); b.st[0] = nloc; b.st[1] = nx; }
        const unsigned old = xb_add(&bar[XB_XSUB(b.x)], 1u);
        const unsigned gen = old / nloc;
        if (old + 1u == (gen + 1u) * nloc) {
            __builtin_amdgcn_fence(__ATOMIC_RELEASE, "agent");
            asm volatile("s_waitcnt vmcnt(0)" ::: "memory");
            const unsigned og = xb_add(&bar[XB_TOP], 1u);
            const unsigned tg = og / nx;
            if (og + 1u == (tg + 1u) * nx) xb_add(&bar[XB_TOPGEN], 1u);
            else XB_SPIN(xb_ld(&bar[XB_TOPGEN]) == tg, bar);
            __builtin_amdgcn_fence(__ATOMIC_ACQUIRE, "agent");
            xb_add(&bar[XB_XGEN(b.x)], 1u);
            asm volatile("s_waitcnt vmcnt(0)" ::: "memory");
        } else {
            XB_SPIN(xb_ld(&bar[XB_XGEN(b.x)]) == gen, bar);
            __builtin_amdgcn_fence(__ATOMIC_ACQUIRE, "agent");
            asm volatile("s_waitcnt vmcnt(0)" ::: "memory");
        }
    }
    __syncthreads();
}


constexpr int XB_LDS_OFF = LDS_BYTES - 64;
constexpr size_t WS_BAR = 0;
struct Args { const float* in[23]; float* out; unsigned char* ws; int ph_lo, ph_hi; };
template <class Epi> __device__ __forceinline__ void run_gemm(const Ctx& C, const bf16_t* A, const bf16_t* Bt, int N, int K, const Epi& E) {
    pg8::Gemm g{A, Bt, M, N, K}; pg8::StaticOrder S; S.init(M, N, C.G, C.bid);
    pg8::gemm_phase<Epi, pg8::StaticOrder, true, true>(C.lds, g, S, E);
}
__global__ void __launch_bounds__(512, 2) fwd_kernel(Args a) {
    extern __shared__ __attribute__((aligned(16))) unsigned char lds_raw[];
    cg::grid_group grid = cg::this_grid();
    Ctx C;
    C.X = a.out; C.ws = a.ws; C.lds = (LAS unsigned char*)lds_raw;
    C.G = gridDim.x; C.bid = blockIdx.x;
    unsigned char* ws = a.ws;
    bf16_t* XN = (bf16_t*)(ws + WS_XN); bf16_t* P1 = (bf16_t*)(ws + WS_P1); bf16_t* OM = (bf16_t*)(ws + WS_OM); bf16_t* YA = (bf16_t*)(ws + WS_YA); bf16_t* YM = (bf16_t*)(ws + WS_HF);
    bf16_t* HH = (bf16_t*)(ws + WS_P1); bf16_t* ZA = (bf16_t*)(ws + WS_P1); bf16_t* ZM = (bf16_t*)(ws + WS_P1 + 64 * MiB);
    if (threadIdx.x < 16) ((LAS unsigned*)(C.lds + XB_LDS_OFF))[threadIdx.x] = 0u;
    __syncthreads();
    XcdBarrier bar = xcd_barrier_post((unsigned*)(ws + WS_BAR), (volatile LAS unsigned*)(C.lds + XB_LDS_OFF));
    for (int ph = a.ph_lo; ph < a.ph_hi; ++ph) {
        { int t_ = threadIdx.x; asm volatile("" : "+v"(t_)); C.tid = t_; C.lane = t_ & 63; C.wave = __builtin_amdgcn_readfirstlane(t_ >> 6); }
        if (ph == 0) {
            prologue_weights(C, a.in[3], a.in[4], a.in[5], a.in[7], a.in[15], a.in[16], a.in[17], a.in[19], a.in[20], a.in[21]); prologue_rope(C, (const int*)a.in[1]);
            norm_pass<0>(C, a.in[0], a.in[2], nullptr, nullptr, nullptr);
        } else {
            const int l = (ph - 1) / NSUB, sp = (ph - 1) % NSUB;
            const unsigned char* wl = ws + WS_W + (size_t)l * W_LAYER;
            switch (sp) {
            case 0: case 9: {
                pg8::EpiSwiGLU E{HH, FF}; run_gemm(C, XN, (const bf16_t*)(wl + (sp == 0 ? WO_GU1 : WO_GU2)), NGU, DM, E); break; }
            case 1: case 10: {
                pg8::EpiResid E{(l == 0 && sp == 1) ? a.in[0] : C.X, C.X, 0.5f};
                run_gemm(C, HH, (const bf16_t*)(wl + (sp == 1 ? WO_D1 : WO_D2)), DM, FF, E);
                break; }
            case 2: norm_pass<1>(C, C.X, a.in[6] + l * DM, nullptr, a.in[7] + (size_t)l * DM * INW, a.in[8] + l * 16); break;
            case 3: { pg8::EpiStore E{P1, P1W, 9, OM, 512}; run_gemm(C, XN, (const bf16_t*)(wl + WO_IN), NINA, DM, E); break; }
            case 4: {
                for (int c = C.bid; c < 256; c += C.G) mlstm_chain(C, c, a.in[12] + (size_t)l * 3 * 1024, a.in[13] + (size_t)l * 1024);
                for (int u = C.bid; u < 512; u += C.G) attn_unit(C, u, a.in[9] + l * 64, a.in[10] + l * 64, a.in[11] + l * 8);
                break; }
            case 5: {
                mc_pass(C, a.in[14] + l * 512);
                { pg8::EpiStore E{ZA, DM, 1 << 20, nullptr, 0}; run_gemm(C, YA, (const bf16_t*)(wl + WO_A), DM, 512, E); }
                { pg8::EpiGate<0> E{ZA, nullptr}; run_gemm(C, XN, (const bf16_t*)(wl + WO_IN) + (size_t)NINA * DM, DM, DM, E); }
                break; }
            case 6: {
                { pg8::EpiStore E{ZM, DM, 1 << 20, nullptr, 0}; run_gemm(C, YM, (const bf16_t*)(wl + WO_B), DM, 512, E); }
                { pg8::EpiGate<1> E{ZA, ZM}; run_gemm(C, XN, (const bf16_t*)(wl + WO_IN) + (size_t)(NINA + 1024) * DM, DM, DM, E); }
                break; }
            case 7: {
                pg8::EpiResid E{C.X, C.X, 1.0f};
                run_gemm(C, ZA, (const bf16_t*)(wl + WO_O), DM, DM, E);
                break; }
            case 8: norm_pass<2>(C, C.X, a.in[18] + l * DM, nullptr, nullptr, nullptr); break;
            case 11: norm_pass<3>(C, C.X, a.in[22] + l * DM, (l + 1 < DEPTH) ? a.in[2] + (l + 1) * DM : nullptr, nullptr, nullptr); break;
            default: break;
            }
        }
        if (ph + 1 < a.ph_hi) { if (a.ph_hi < 0) grid.sync(); else xcd_barrier(bar); }
    }
}
}

#ifndef MK_MULTI
#define MK_MULTI 0
#endif
extern "C" void kernel_launch(void* const* d_in, const int* in_sizes, int n_in, void* d_out, int out_size, void* d_ws, size_t ws_size, hipStream_t stream) {
    using namespace mk;
    static int grid = 0;
    if (grid == 0) {
        if (n_in != 23 || out_size != M * DM || ws_size < WS_END) { fprintf(stderr, "kernel_launch: unexpected sizes (n_in %d out %d ws %zu)\n", n_in, out_size, ws_size); grid = -1; return; }
        int dev = 0, cus = 0, per_cu = 0;
        (void)hipGetDevice(&dev); (void)hipDeviceGetAttribute(&cus, hipDeviceAttributeMultiprocessorCount, dev);
        (void)hipFuncSetAttribute((const void*)fwd_kernel, hipFuncAttributeMaxDynamicSharedMemorySize, LDS_BYTES);
        if (hipOccupancyMaxActiveBlocksPerMultiprocessor(&per_cu, (const void*)fwd_kernel, 512, LDS_BYTES) != hipSuccess || per_cu < 1) per_cu = 1;
        (void)hipGetLastError();
        if (per_cu > 1) per_cu = 1;
        grid = cus * per_cu; if (grid <= 0) grid = 256;
    }
    if (grid < 0) return;
    (void)hipMemsetAsync((char*)d_ws + WS_BAR, 0, XCD_BAR_WORDS * 4, stream);
    Args a{};
    for (int i = 0; i < 23; ++i) a.in[i] = (const float*)d_in[i];
    a.out = (float*)d_out; a.ws = (unsigned char*)d_ws;
#if MK_MULTI
    for (int ph = 0; ph < NPHASE; ++ph) { a.ph_lo = ph; a.ph_hi = ph + 1; hipLaunchKernelGGL(fwd_kernel, dim3(grid), dim3(512), LDS_BYTES, stream, a); }
#else
    a.ph_lo = 0; a.ph_hi = NPHASE;
    void* args[] = {&a};
    hipError_t e = hipLaunchCooperativeKernel((const void*)fwd_kernel, dim3(grid), dim3(512), args, LDS_BYTES, stream);
    if (e != hipSuccess) fprintf(stderr, "cooperative launch failed: %s (grid %d)\n", hipGetErrorString(e), grid);
#endif
}
```
